# Optimizing an MI355X kernel written in HIP

```python
import jax
import jax.numpy as jnp
from jax import lax
import numpy as np

D_MODEL = 1024
BATCH = 8
SEQ = 4096
DEPTH = 4

CTX_LEN = 256
GRID_W = 64
N_DIR = 2
MIX_W = 512
N_BRANCH = 3
HG_HEADS = 4
HG_DK = 128
HG_DV = MIX_W // HG_HEADS
ML_HEADS = 4
ML_DV = MIX_W // ML_HEADS
ML_DQK = ML_DV // 2
LRU_W = MIX_W
LRU_BLOCKS = 8
LRU_BD = LRU_W // LRU_BLOCKS
LRU_C = 8.0
CONV_W = 4
CONV_LEFT = 2
FFN_HIDDEN = ((8 * D_MODEL // 3 + 255) // 256) * 256
CHUNK = 64
EPS = 1e-6
NEG_BIG = -1e30
LB_TINY = 1e-30
IN_SIZES = (
    HG_HEADS * HG_DK,
    HG_HEADS * HG_DV,
    HG_HEADS * HG_DV,
    N_DIR * HG_HEADS * HG_DK,
    ML_HEADS * ML_DQK,
    ML_HEADS * ML_DQK,
    ML_HEADS * ML_DV,
    ML_HEADS * ML_DV,
    N_DIR * ML_HEADS,
    N_DIR * ML_HEADS,
    LRU_W,
    LRU_W,
    N_BRANCH * D_MODEL,
)
N_IN = sum(IN_SIZES)
ML_FGATE_IDX = 9
N_MIX_PARTS = 12

kernel_name = 'hybrid_hgrn2_mlstm_rglru_dit_trunk'


def rms_norm(x, w):
    xf = x.astype(jnp.float32)
    y = xf * lax.rsqrt(jnp.mean(xf * xf, axis=-1, keepdims=True) + EPS)
    return (y * w).astype(x.dtype)


def modulate(h, shift, scale):
    return h * (1 + scale) + shift


def grid_transpose(h, rows, cols):
    b, _, d = h.shape
    return h.reshape(b, rows, cols, d).transpose(0, 2, 1, 3).reshape(b, rows * cols, d)


def split_in(u):
    return jnp.split(u, np.cumsum(IN_SIZES)[:-1].tolist(), axis=-1)


def to_heads(a, n_heads):
    b, t, _ = a.shape
    return a.reshape(b, t, n_heads, -1).transpose(0, 2, 1, 3)


def to_chunks(a):
    b, h, t = a.shape[:3]
    return jnp.moveaxis(a.reshape(b, h, t // CHUNK, CHUNK, *a.shape[3:]), 2, 0)


def from_chunks(a):
    a = jnp.moveaxis(a, 0, 2)
    return a.reshape(a.shape[0], a.shape[1], -1, *a.shape[4:])


def head_rms_norm(h, w):
    h = h * lax.rsqrt(jnp.mean(h * h, axis=-1, keepdims=True) + EPS)
    b, nh, t, dh = h.shape
    return h.transpose(0, 2, 1, 3).reshape(b, t, nh * dh) * w


def _orient(a, axis, rev):
    return jnp.flip(a, axis) if rev else a


def hgrn2_chunkwise(q, k, v, log_f, s0):
    mask = jnp.tril(jnp.ones((CHUNK, CHUNK), dtype=bool))[:, :, None]

    def step(s_prev, inp):
        qc, kc, vc, gc = inp
        b = jnp.cumsum(gc, axis=2)
        log_decay = jnp.where(mask, b[:, :, :, None, :] - b[:, :, None, :, :], NEG_BIG)
        scores = jnp.einsum('bhtk,bhsk,bhtsk->bhts', qc, kc, jnp.exp(log_decay))
        o = scores @ vc + (qc * jnp.exp(b)) @ s_prev
        b_last = b[:, :, -1:, :]
        s_new = (jnp.exp(b_last[:, :, 0, :, None]) * s_prev
                 + jnp.einsum('bhsk,bhsv->bhkv', kc * jnp.exp(b_last - b), vc))
        return s_new, o

    s_last, o = lax.scan(step, s0, tuple(to_chunks(a) for a in (q, k, v, log_f)))
    return from_chunks(o), s_last


def mlstm_chunkwise(q, k, v, log_i, log_f, state):
    mask = jnp.tril(jnp.ones((CHUNK, CHUNK), dtype=bool))

    def step(carry, inp):
        c_mem, n_mem, m_prev = carry
        qc, kc, vc, ic, fc = inp
        b = jnp.cumsum(fc, axis=-1)
        log_d = jnp.where(mask, b[..., :, None] - b[..., None, :] + ic[..., None, :], NEG_BIG)
        log_inter = b + m_prev[..., None]
        m_row = jnp.maximum(jnp.max(log_d, axis=-1), log_inter)
        s = jnp.einsum('bhtk,bhsk->bhts', qc, kc) * jnp.exp(log_d - m_row[..., None])
        w_inter = jnp.exp(log_inter - m_row)
        num = s @ vc + w_inter[..., None] * (qc @ c_mem)
        den = jnp.sum(s, axis=-1) + w_inter * jnp.einsum('bhtk,bhk->bht', qc, n_mem)
        h = num / jnp.maximum(jnp.abs(den), jnp.exp(-m_row))[..., None]
        b_last = b[..., -1]
        log_w = b_last[..., None] - b + ic
        m_new = jnp.maximum(b_last + m_prev, jnp.max(log_w, axis=-1))
        w_s = jnp.exp(log_w - m_new[..., None])
        carry_decay = jnp.exp(b_last + m_prev - m_new)
        c_new = carry_decay[..., None, None] * c_mem + jnp.einsum('bhs,bhsk,bhsv->bhkv', w_s, kc, vc)
        n_new = carry_decay[..., None] * n_mem + jnp.einsum('bhs,bhsk->bhk', w_s, kc)
        return (c_new, n_new, m_new), h

    carry, h = lax.scan(step, state, tuple(to_chunks(a) for a in (q, k, v, log_i, log_f)))
    return from_chunks(h), carry


def _linear_combine(left, right):
    a_l, b_l = left
    a_r, b_r = right
    return a_l * a_r, a_r * b_l + b_r


def rglru(xc, r_pre, i_pre, lam, h0):
    log_a = -LRU_C * jax.nn.softplus(-lam) * jax.nn.sigmoid(r_pre)
    a = jnp.exp(log_a)
    u = jnp.sqrt(jnp.maximum(-jnp.expm1(2.0 * log_a), 0.0)) * (jax.nn.sigmoid(i_pre) * xc)
    a_cum, h = lax.associative_scan(_linear_combine, (a, u), axis=1)
    h = h + a_cum * h0[:, None, :]
    return h, h[:, -1]


def depthwise_conv(x, w, b):
    t = x.shape[1]
    xp = jnp.pad(x, ((0, 0), (CONV_LEFT, CONV_W - 1 - CONV_LEFT), (0, 0)))
    return sum(xp[:, j:j + t] * w[j] for j in range(CONV_W)) + b


def zero_states(batch):
    f32 = jnp.float32
    one = (jnp.zeros((batch, HG_HEADS, HG_DK, HG_DV), f32),
           jnp.zeros((batch, ML_HEADS, ML_DQK, ML_DV), f32),
           jnp.zeros((batch, ML_HEADS, ML_DQK), f32),
           jnp.zeros((batch, ML_HEADS), f32),
           jnp.zeros((batch, LRU_W), f32))
    return (one, one)


def token_mixers(parts, lb, hg_norm_w, ml_norm_w, conv_w, conv_b, lru_gate_w, lru_gate_b,
                 lru_lambda, init, with_outputs):
    hg_q, hg_i, hg_g, hg_f, ml_q, ml_k, ml_v, ml_o, ml_ig, ml_fg, lru_x, lru_y = parts
    f32 = jnp.float32
    dt = hg_q.dtype
    bsz, t, _ = hg_q.shape
    q_hg = to_heads(jax.nn.silu(hg_q.astype(f32)), HG_HEADS)
    v_hg = to_heads(hg_i.astype(f32), HG_HEADS)
    f_pre = hg_f.astype(f32).reshape(bsz, t, N_DIR, HG_HEADS * HG_DK)
    log_lb = jnp.log(jnp.maximum(lb, LB_TINY))
    logf_hg = jnp.logaddexp(log_lb, jnp.log1p(-lb) + jax.nn.log_sigmoid(f_pre))
    k_hg = (1.0 - lb) * jax.nn.sigmoid(-f_pre)
    q_ml = to_heads(ml_q.astype(f32), ML_HEADS) * ML_DQK ** -0.5
    k_ml = to_heads(ml_k.astype(f32), ML_HEADS)
    v_ml = to_heads(ml_v.astype(f32), ML_HEADS)
    logi_ml = ml_ig.astype(f32).reshape(bsz, t, N_DIR, ML_HEADS).transpose(2, 0, 3, 1)
    logf_ml = jax.nn.log_sigmoid(ml_fg.astype(f32).reshape(bsz, t, N_DIR, ML_HEADS)).transpose(2, 0, 3, 1)
    xc = depthwise_conv(lru_x, conv_w, conv_b).astype(f32)
    gates = jnp.einsum('btnd,zgnde->zgbtne', xc.reshape(bsz, t, LRU_BLOCKS, LRU_BD),
                       lru_gate_w.astype(f32)).reshape(N_DIR, 2, bsz, t, LRU_W)
    gates = gates + lru_gate_b.astype(f32)[:, :, None, None, :]

    o_hg = 0.0
    h_ml = 0.0
    h_lru = 0.0
    finals = []
    for d in range(N_DIR):
        rev = d == 1
        s_hg, c_ml, n_ml, m_ml, s_lru = init[d]
        o, s_hg = hgrn2_chunkwise(_orient(q_hg, 2, rev),
                                  _orient(to_heads(k_hg[:, :, d], HG_HEADS), 2, rev),
                                  _orient(v_hg, 2, rev),
                                  _orient(to_heads(logf_hg[:, :, d], HG_HEADS), 2, rev), s_hg)
        o_hg = o_hg + _orient(o, 2, rev)
        h, (c_ml, n_ml, m_ml) = mlstm_chunkwise(_orient(q_ml, 2, rev), _orient(k_ml, 2, rev),
                                                _orient(v_ml, 2, rev), _orient(logi_ml[d], 2, rev),
                                                _orient(logf_ml[d], 2, rev), (c_ml, n_ml, m_ml))
        h_ml = h_ml + _orient(h, 2, rev)
        hl, s_lru = rglru(_orient(xc, 1, rev), _orient(gates[d, 0], 1, rev),
                          _orient(gates[d, 1], 1, rev), lru_lambda[d].astype(f32), s_lru)
        h_lru = h_lru + _orient(hl, 1, rev)
        finals.append((s_hg, c_ml, n_ml, m_ml, s_lru))
    if not with_outputs:
        return None, finals
    a_out = head_rms_norm(o_hg, hg_norm_w) * jax.nn.silu(hg_g.astype(f32))
    b_out = head_rms_norm(h_ml, ml_norm_w) * jax.nn.sigmoid(ml_o.astype(f32))
    c_out = h_lru * jax.nn.gelu(lru_y.astype(f32))
    return (a_out.astype(dt), b_out.astype(dt), c_out.astype(dt)), finals


def merge_branches(branches, gate_pre, w_branch, w_out):
    bsz, t, _ = gate_pre.shape
    g = jax.nn.sigmoid(gate_pre.reshape(bsz, t, N_BRANCH, D_MODEL))
    merged = sum(g[:, :, n] * (branches[n] @ w_branch[n]) for n in range(N_BRANCH))
    return merged @ w_out


def swiglu(h, w_in, w_out):
    gate, up = jnp.split(h @ w_in, 2, axis=-1)
    return (jax.nn.silu(gate) * up) @ w_out


def setup_inputs(seed: int = 0) -> dict:
    key = jax.random.key(seed)
    ks = jax.random.split(key, 24)
    f32 = jnp.float32

    def nrm(k, shape, fan_in):
        return jax.random.normal(k, shape, f32) * fan_in ** -0.5

    def small(k, shape):
        return 0.02 * jax.random.normal(k, shape, f32)

    b_in = small(ks[8], (DEPTH, N_IN))
    f_off = int(sum(IN_SIZES[:ML_FGATE_IDX]))
    f_bias = jnp.tile(jnp.linspace(3.0, 6.0, ML_HEADS, dtype=f32), N_DIR)
    b_in = b_in.at[:, f_off:f_off + N_DIR * ML_HEADS].add(f_bias)
    a_base = jax.random.uniform(ks[16], (DEPTH, N_DIR, LRU_W), f32, 0.9, 0.999)
    s_base = a_base ** (1.0 / LRU_C)
    return {
        'x': jax.random.normal(ks[0], (BATCH, SEQ, D_MODEL), f32),
        'c': jax.random.normal(ks[1], (BATCH, D_MODEL), f32),
        'ctx': jax.random.normal(ks[2], (BATCH, CTX_LEN, D_MODEL), f32),
        'c_ctx': jax.random.normal(ks[3], (D_MODEL,), f32),
        'w_ada': 0.5 * nrm(ks[4], (DEPTH, D_MODEL, 6 * D_MODEL), D_MODEL),
        'b_ada': small(ks[5], (DEPTH, 6 * D_MODEL)),
        'ln1': 1.0 + small(ks[6], (DEPTH, D_MODEL)),
        'w_in': nrm(ks[7], (DEPTH, D_MODEL, N_IN), D_MODEL),
        'b_in': b_in,
        'hg_lb_raw': 0.5 * jax.random.normal(ks[9], (DEPTH, N_DIR, HG_HEADS * HG_DK), f32),
        'hg_norm': 1.0 + small(ks[10], (DEPTH, MIX_W)),
        'ml_norm': 1.0 + small(ks[11], (DEPTH, MIX_W)),
        'conv_w': nrm(ks[12], (DEPTH, CONV_W, LRU_W), CONV_W),
        'conv_b': small(ks[13], (DEPTH, LRU_W)),
        'lru_gate_w': nrm(ks[14], (DEPTH, N_DIR, 2, LRU_BLOCKS, LRU_BD, LRU_BD), LRU_BD),
        'lru_gate_b': small(ks[15], (DEPTH, N_DIR, 2, LRU_W)),
        'lru_lambda': jnp.log(s_base) - jnp.log1p(-s_base),
        'w_branch': nrm(ks[17], (DEPTH, N_BRANCH, MIX_W, D_MODEL), MIX_W),
        'w_out': nrm(ks[18], (DEPTH, D_MODEL, D_MODEL), D_MODEL),
        'ln2': 1.0 + small(ks[19], (DEPTH, D_MODEL)),
        'w_ffn_in': nrm(ks[20], (DEPTH, D_MODEL, 2 * FFN_HIDDEN), D_MODEL),
        'w_ffn_out': nrm(ks[21], (DEPTH, FFN_HIDDEN, D_MODEL), FFN_HIDDEN),
        'final_norm': 1.0 + small(ks[22], (D_MODEL,)),
    }


def reference(x, c, ctx, c_ctx, w_ada, b_ada, ln1, w_in, b_in, hg_lb_raw, hg_norm, ml_norm,
              conv_w, conv_b, lru_gate_w, lru_gate_b, lru_lambda, w_branch, w_out, ln2,
              w_ffn_in, w_ffn_out, final_norm):
    bsz, seq, _ = x.shape
    rows = seq // GRID_W
    lb_p = jax.nn.softmax(hg_lb_raw.astype(jnp.float32), axis=0)
    lb_all = jnp.cumsum(lb_p, axis=0) - lb_p[0]
    sc = jax.nn.silu(c)
    sc_ctx = jax.nn.silu(c_ctx)
    for l in range(DEPTH):
        last = l == DEPTH - 1
        col_major = l % 2 == 1
        mod = jnp.split(sc @ w_ada[l] + b_ada[l], 6, axis=-1)
        mod_c = jnp.split(sc_ctx @ w_ada[l] + b_ada[l], 6, axis=-1)
        mix_params = (lb_all[l], hg_norm[l], ml_norm[l], conv_w[l], conv_b[l],
                      lru_gate_w[l], lru_gate_b[l], lru_lambda[l])
        hx = modulate(rms_norm(x, ln1[l]), mod[0][:, None], mod[1][:, None])
        hc = modulate(rms_norm(ctx, ln1[l]), mod_c[0], mod_c[1])
        if col_major:
            hx = grid_transpose(hx, rows, GRID_W)
        px = split_in(hx @ w_in[l] + b_in[l])
        pc = split_in(hc @ w_in[l] + b_in[l])
        br_c, st_c = token_mixers(pc[:N_MIX_PARTS], *mix_params, zero_states(ctx.shape[0]), not last)
        br_x, _ = token_mixers(px[:N_MIX_PARTS], *mix_params, st_c, True)
        yx = merge_branches(br_x, px[N_MIX_PARTS], w_branch[l], w_out[l])
        if col_major:
            yx = grid_transpose(yx, GRID_W, rows)
        x = x + mod[2][:, None] * yx
        x = x + mod[5][:, None] * swiglu(
            modulate(rms_norm(x, ln2[l]), mod[3][:, None], mod[4][:, None]), w_ffn_in[l], w_ffn_out[l])
        if not last:
            ctx = ctx + mod_c[2] * merge_branches(br_c, pc[N_MIX_PARTS], w_branch[l], w_out[l])
            ctx = ctx + mod_c[5] * swiglu(
                modulate(rms_norm(ctx, ln2[l]), mod_c[3], mod_c[4]), w_ffn_in[l], w_ffn_out[l])
    return rms_norm(x, final_norm)
```

```cpp
#include <hip/hip_runtime.h>
#include <hip/hip_cooperative_groups.h>
#include <cstdio>
#include <cstdint>
namespace cg = cooperative_groups;
#ifndef PROBE_MIX
#define PROBE_MIX 0
#endif
#ifndef PROBE_FFN
#define PROBE_FFN 0
#endif
#ifndef PROBE_BR
#define PROBE_BR 0
#endif
#define PG8_ALIGN_V true
#define PG8_SP2_V true
namespace pg8 {
#define PG8_LAS __attribute__((address_space(3)))
typedef unsigned short bf16_t;
typedef short bf16x8 __attribute__((ext_vector_type(8)));
typedef float f32x4 __attribute__((ext_vector_type(4)));
typedef unsigned u32x4 __attribute__((ext_vector_type(4)));
constexpr int BM = 256, BK = 64, HALF = 128, HTB = HALF * BK * 2  , STAGE_BYTES = 8 * HTB, NXCD = 8, WGM = 8;

__host__ __device__ __forceinline__ int lds_byte(int r, int c) { const int st = (r >> 4) * 2 + (c >> 5), rr = r & 15, cc = c & 31, ob = rr * 64 + cc * 2; return st * 1024 + (ob ^ (((ob >> 9) & 1) << 5)); }
__host__ __device__ __forceinline__ void stage_rc(int b, int& R, int& C) { const int st = b / 1024, sb = b % 1024, swz = sb ^ (((sb >> 9) & 1) << 5); R = (st >> 1) * 16 + swz / 64; C = (st & 1) * 32 + (swz % 64) / 2; }
__host__ __device__ __forceinline__ int perm32(int rho) { const int n = rho >> 4, i = rho & 15; return 8 * (i >> 2) + 4 * n + (i & 3); }

struct Unit { int pm, pn; };
struct Gemm { const bf16_t* A; const bf16_t* Bt; int M, N, K; };

struct StaticOrder {
    int nM, nN, nwg, G, c;
    __host__ __device__ void init(int M, int N, int G_, int c_) { nM = M / BM; nN = N / BM; nwg = nM * nN; G = G_; c = c_; }
    __host__ __device__ bool next(int i, Unit& u) const {
        const long L = (long)i * G + c; if (L >= nwg) return false;
        int wgid = (int)L; { const int q = nwg / NXCD, r = nwg % NXCD, xcd = wgid % NXCD, off = wgid / NXCD; wgid = (xcd < r ? xcd * (q + 1) : r * (q + 1) + (xcd - r) * q) + off; }
        const int nig = WGM * nN, gid = wgid / nig, fm = gid * WGM, gsz = (nM - fm) < WGM ? (nM - fm) : WGM;
        u.pm = fm + ((wgid % nig) % gsz); u.pn = (wgid % nig) / gsz; return true;
    }
    __device__ __forceinline__ void a_ready(const Unit&) const {}
    __device__ __forceinline__ void done(const Unit&) const {}
};
__device__ __forceinline__ unsigned cvt_pk_bf16(float lo, float hi) { unsigned r; asm volatile("v_cvt_pk_bf16_f32 %0, %1, %2" : "=v"(r) : "v"(lo), "v"(hi)); return r; }
typedef float f32x2 __attribute__((ext_vector_type(2)));
template <class Epi, class Sched, bool ALIGN_EPI = false, bool SP2 = false>
__device__ __forceinline__ void gemm_phase(PG8_LAS unsigned char* lds, const Gemm g, const Sched& S, const Epi& E) {
    int tid_ = threadIdx.x; asm volatile("" : "+v"(tid_)); const int tid = tid_, wid = __builtin_amdgcn_readfirstlane(tid >> 6), lane = tid & 63, wr = wid >> 2, wc = wid & 3, fr = lane & 15, fq = lane >> 4;
    const int K = g.K, nt = K / BK;
    unsigned voffA[2], voffB[2];
#pragma unroll
    for (int i = 0; i < 2; ++i) { int R, C; stage_rc(tid * 16 + i * 8192, R, C); const int Rb = Epi::PERM ? ((R & ~31) + perm32(R & 31)) : R;
        voffA[i] = (unsigned)(R * K + C) * 2u; voffB[i] = (unsigned)(Rb * K + C) * 2u; }
    const size_t kstep = (size_t)(BK * 2);
    const size_t hstep = (size_t)HALF * K * 2;
    const size_t tstep = 2 * hstep;
    const unsigned ldsw = (unsigned)wid * 1024u;
    const int aoff = lds_byte(wr * 64 + fr, fq * 8), boff = lds_byte(wc * 32 + fr, fq * 8);
#define PG8_SA(b, h) (((b) * 2 + (h)) * HTB)
#define PG8_SB(b, h) ((4 + (b) * 2 + (h)) * HTB)
#define PG8_STAGE(bufoff, gbase, voff) do { _Pragma("unroll") for (int _i = 0; _i < 2; ++_i) \
        __builtin_amdgcn_global_load_lds((const unsigned*)((const char*)(gbase) + (voff)[_i]), (PG8_LAS unsigned*)(lds + (bufoff) + ldsw + _i * 8192), 16, 0, 0); } while (0)
#define PG8_LDA(dst, b, h) do { _Pragma("unroll") for (int m = 0; m < 4; ++m) _Pragma("unroll") for (int k = 0; k < 2; ++k) dst[m][k] = *(const PG8_LAS bf16x8*)(lds + PG8_SA(b, h) + aoff + m * 2048 + k * 1024); } while (0)
#define PG8_LDB(dst, b, h) do { _Pragma("unroll") for (int n = 0; n < 2; ++n) _Pragma("unroll") for (int k = 0; k < 2; ++k) dst[n][k] = *(const PG8_LAS bf16x8*)(lds + PG8_SB(b, h) + boff + n * 2048 + k * 1024); } while (0)
#define PG8_MMA(ai, bj, At, Bt) do { __builtin_amdgcn_s_setprio(1); _Pragma("unroll") for (int m = 0; m < 4; ++m) _Pragma("unroll") for (int n = 0; n < 2; ++n) _Pragma("unroll") for (int k = 0; k < 2; ++k) \
        acc[ai][bj][m][n] = __builtin_amdgcn_mfma_f32_16x16x32_bf16(Bt[n][k], At[m][k], acc[ai][bj][m][n], 0, 0, 0); __builtin_amdgcn_s_setprio(0); } while (0)
#define PG8_WAIT_V(n) asm volatile("s_waitcnt vmcnt(" #n ")" ::: "memory")
#define PG8_WAIT_L(n) asm volatile("s_waitcnt lgkmcnt(" #n ")" ::: "memory")
#define PG8_BAR __builtin_amdgcn_s_barrier()
#define PG8_SCHED __builtin_amdgcn_sched_barrier(0)
    Unit cur, nxt; int ui = 0;
    if (!S.next(0, cur)) return;
    f32x4 acc[2][2][4][2];
#pragma unroll
    for (int a = 0; a < 2; ++a)
#pragma unroll
        for (int b = 0; b < 2; ++b)
#pragma unroll
            for (int m = 0; m < 4; ++m)
#pragma unroll
                for (int n = 0; n < 2; ++n) acc[a][b][m][n] = (f32x4){0.f, 0.f, 0.f, 0.f};
    bf16x8 At[4][2], B0[2][2], B1[2][2];
    const char* cA = (const char*)g.A + (size_t)cur.pm * tstep; const char* cB = (const char*)g.Bt + (size_t)cur.pn * tstep;
    S.a_ready(cur);
    if constexpr (SP2) {
        PG8_STAGE(PG8_SB(0, 0), cB, voffB); PG8_STAGE(PG8_SB(0, 1), cB + hstep, voffB); PG8_STAGE(PG8_SA(0, 0), cA, voffA); PG8_STAGE(PG8_SA(0, 1), cA + hstep, voffA);
        if (wr == 1) PG8_BAR;
        PG8_WAIT_V(2); PG8_BAR;
        PG8_STAGE(PG8_SB(1, 0), cB + kstep, voffB); PG8_STAGE(PG8_SA(1, 0), cA + kstep, voffA); PG8_STAGE(PG8_SB(1, 1), cB + hstep + kstep, voffB);
        PG8_WAIT_V(6); PG8_BAR;
    } else {
        PG8_STAGE(PG8_SB(0, 0), cB, voffB); PG8_STAGE(PG8_SA(0, 0), cA, voffA); PG8_STAGE(PG8_SB(0, 1), cB + hstep, voffB); PG8_STAGE(PG8_SA(0, 1), cA + hstep, voffA);
        if (wr == 1) PG8_BAR;
        PG8_WAIT_V(4); PG8_BAR;
        PG8_STAGE(PG8_SB(1, 0), cB + kstep, voffB); PG8_STAGE(PG8_SA(1, 0), cA + kstep, voffA); PG8_STAGE(PG8_SB(1, 1), cB + hstep + kstep, voffB);
        PG8_WAIT_V(6); PG8_BAR;
    }
    for (;;) {
        const bool has_next = S.next(ui + 1, nxt);
        const char* nA = has_next ? (const char*)g.A + (size_t)nxt.pm * tstep : cA; const char* nB = has_next ? (const char*)g.Bt + (size_t)nxt.pn * tstep : cB;
        for (int t = 0; t < nt; t += 2) {
            const bool last = (t == nt - 2);
            if constexpr (Epi::HAS_MID) { if (t == 8 || t == 16) E.mid(acc, cur, t >> 3, wr, wc, fr, fq); }
            const char* a1 = cA + (size_t)(t + 1) * kstep;
            const char* a2 = last ? nA : cA + (size_t)(t + 2) * kstep; const char* b2 = last ? nB : cB + (size_t)(t + 2) * kstep;
            const char* a3 = a2 + kstep; const char* b3 = b2 + kstep;
            if (last && has_next) S.a_ready(nxt);
            if constexpr (SP2) {
            PG8_LDB(B0, 0, 0); PG8_LDB(B1, 0, 1); PG8_SCHED; PG8_LDA(At, 0, 0); PG8_STAGE(PG8_SA(1, 1), a1 + hstep, voffA);
            PG8_WAIT_V(8); PG8_WAIT_L(0); PG8_BAR; PG8_MMA(0, 0, At, B0); PG8_MMA(0, 1, At, B1); PG8_BAR; PG8_SCHED;
            PG8_LDA(At, 0, 1); PG8_STAGE(PG8_SB(0, 0), b2, voffB); PG8_STAGE(PG8_SB(0, 1), b2 + hstep, voffB); PG8_STAGE(PG8_SA(0, 0), a2, voffA);
            PG8_WAIT_V(8); PG8_WAIT_L(0); PG8_BAR; PG8_MMA(1, 0, At, B0); PG8_MMA(1, 1, At, B1); PG8_BAR; PG8_SCHED;
            PG8_LDB(B0, 1, 0); PG8_LDB(B1, 1, 1); PG8_SCHED; PG8_LDA(At, 1, 0); PG8_STAGE(PG8_SA(0, 1), a2 + hstep, voffA);
            PG8_WAIT_V(8); PG8_WAIT_L(0); PG8_BAR; PG8_MMA(0, 0, At, B0); PG8_MMA(0, 1, At, B1); PG8_BAR; PG8_SCHED;
            PG8_LDA(At, 1, 1); PG8_STAGE(PG8_SB(1, 0), b3, voffB); PG8_STAGE(PG8_SB(1, 1), b3 + hstep, voffB); PG8_STAGE(PG8_SA(1, 0), a3, voffA);
            PG8_WAIT_V(8); PG8_WAIT_L(0); PG8_BAR; PG8_MMA(1, 0, At, B0); PG8_MMA(1, 1, At, B1); PG8_BAR; PG8_SCHED;
            } else {
            PG8_LDB(B0, 0, 0); PG8_SCHED; PG8_LDA(At, 0, 0); PG8_STAGE(PG8_SA(1, 1), a1 + hstep, voffA);
            PG8_WAIT_L(8); PG8_BAR; PG8_WAIT_L(0); PG8_MMA(0, 0, At, B0); PG8_BAR; PG8_SCHED;
            PG8_LDB(B1, 0, 1); PG8_STAGE(PG8_SB(0, 0), b2, voffB);
            PG8_BAR; PG8_WAIT_L(0); PG8_MMA(0, 1, At, B1); PG8_BAR;
            PG8_LDA(At, 0, 1); PG8_STAGE(PG8_SA(0, 0), a2, voffA);
            PG8_BAR; PG8_WAIT_L(0); PG8_MMA(1, 0, At, B0); PG8_BAR; PG8_SCHED;
            PG8_STAGE(PG8_SB(0, 1), b2 + hstep, voffB);
            PG8_WAIT_V(6); PG8_BAR; PG8_MMA(1, 1, At, B1); PG8_BAR;
            PG8_LDB(B0, 1, 0); PG8_SCHED; PG8_LDA(At, 1, 0); PG8_STAGE(PG8_SA(0, 1), a2 + hstep, voffA);
            PG8_WAIT_L(8); PG8_BAR; PG8_WAIT_L(0); PG8_MMA(0, 0, At, B0); PG8_BAR; PG8_SCHED;
            PG8_LDB(B1, 1, 1); PG8_STAGE(PG8_SB(1, 0), b3, voffB);
            PG8_BAR; PG8_WAIT_L(0); PG8_MMA(0, 1, At, B1); PG8_BAR;
            PG8_LDA(At, 1, 1); PG8_STAGE(PG8_SA(1, 0), a3, voffA);
            PG8_BAR; PG8_WAIT_L(0); PG8_MMA(1, 0, At, B0); PG8_BAR; PG8_SCHED;
            PG8_STAGE(PG8_SB(1, 1), b3 + hstep, voffB);
            PG8_WAIT_V(6); PG8_BAR; PG8_MMA(1, 1, At, B1); PG8_BAR;
            }
        }
        if constexpr (ALIGN_EPI) { if (wr == 0) PG8_BAR; }
        if constexpr (!Epi::AFTER_DRAIN) { E(acc, cur, wr, wc, fr, fq); S.done(cur); }
        if (!has_next) break;
#pragma unroll
        for (int a = 0; a < 2; ++a)
#pragma unroll
            for (int b = 0; b < 2; ++b)
#pragma unroll
                for (int m = 0; m < 4; ++m)
#pragma unroll
                    for (int n = 0; n < 2; ++n) acc[a][b][m][n] = (f32x4){0.f, 0.f, 0.f, 0.f};
        cur = nxt; cA = nA; cB = nB; ++ui;
        if constexpr (ALIGN_EPI) { if (wr == 1) PG8_BAR; }
    }
    PG8_WAIT_V(0);
    if constexpr (!ALIGN_EPI) { if (wr == 0) PG8_BAR; }
    PG8_BAR;
    if constexpr (Epi::AFTER_DRAIN) { E.fused(acc, cur, wr, wc, fr, fq, lds, wid, lane); S.done(cur); }
#undef PG8_SA
#undef PG8_SB
#undef PG8_STAGE
#undef PG8_LDA
#undef PG8_LDB
#undef PG8_MMA
#undef PG8_WAIT_V
#undef PG8_WAIT_L
#undef PG8_BAR
#undef PG8_SCHED
}
}

#define LAS __attribute__((address_space(3)))
#define DI __device__ __forceinline__
typedef unsigned short bf16_t;
typedef short bf16x8 __attribute__((ext_vector_type(8)));
typedef float f32x4 __attribute__((ext_vector_type(4)));
typedef unsigned u32x4 __attribute__((ext_vector_type(4)));
typedef unsigned u32x2 __attribute__((ext_vector_type(2)));

constexpr int D = 1024, NB = 8, SEQ = 4096, DEPTH = 4, CTXL = 256;
constexpr int MX = NB * SEQ, MC = NB * CTXL, MT = MX + MC;
constexpr int NIN = 8208, NP = 3584, N1 = 5376, NG = 3072, FF = 2816, NW1 = N1 + NG;
constexpr float EPS = 1e-6f;
constexpr float LOG2E = 1.4426950408889634f;
constexpr size_t MiB = 1u << 20;
constexpr size_t WS_MOD = 0;
constexpr size_t WS_BIAS = 1 * MiB;
constexpr size_t WS_CTL = 5 * MiB;
constexpr size_t WS_LB = 1 * MiB + 262144;
constexpr size_t WS_MLG = 2 * MiB;
constexpr size_t WS_W = 6 * MiB;
constexpr size_t W_W1 = 0, W_BR = (size_t)NW1 * 1024 * 2, W_O = W_BR + 3ull * 1024 * 512 * 2, W_FI = W_O + 1024ull * 1024 * 2, W_FO = W_FI + 5632ull * 1024 * 2, W_END = W_FO + 1024ull * 2816 * 2;
constexpr size_t WS_CTXW = 46 * MiB;
constexpr size_t WS_AS = 54 * MiB;
constexpr size_t WS_SL = 122 * MiB;
constexpr size_t WS_BR = 156 * MiB;
constexpr size_t WS_P = 258 * MiB;
constexpr size_t WS_W2 = 258 * MiB + (size_t)MT * NP * 2;
constexpr size_t WS_END = WS_W2 + 39845888;
static_assert(W_END <= 39845888, "weights");
constexpr int LDS_BYTES = 155648;

DI float ex2(float x) { return __builtin_amdgcn_exp2f(x); }
DI float lg2(float x) { return __builtin_amdgcn_logf(x); }
DI float rcpf_(float x) { return __builtin_amdgcn_rcpf(x); }
DI float sigm(float x) { return rcpf_(1.f + ex2(-LOG2E * x)); }
DI float silu_(float x) { return x * sigm(x); }
DI float gelu_t(float x) { const float u = 1.5957691216f * (x + 0.044715f * x * x * x); return x * sigm(u); }
typedef __bf16 bf2_t __attribute__((ext_vector_type(2)));
DI unsigned pk2(float lo, float hi) { bf2_t v = { (__bf16)lo, (__bf16)hi }; return __builtin_bit_cast(unsigned, v); }
DI float bflo(unsigned w) { return __uint_as_float(w << 16); }
DI float bfhi(unsigned w) { return __uint_as_float(w & 0xffff0000u); }
DI float bf1(bf16_t h) { return __uint_as_float(((unsigned)h) << 16); }
DI float wave_sum(float v) {
#pragma unroll
    for (int o = 1; o < 64; o <<= 1) v += __shfl_xor(v, o);
    return v;
}
DI f32x4 mfma16(bf16x8 a, bf16x8 b, f32x4 c) { return __builtin_amdgcn_mfma_f32_16x16x32_bf16(a, b, c, 0, 0, 0); }
DI bf16x8 ldfrag(const LAS bf16_t* base, int ld, int r0, int k0, int lane) { return *(const LAS bf16x8*)(base + (r0 + (lane & 15)) * ld + k0 + (lane >> 4) * 8); }

DI int otid() { int t = threadIdx.x; asm volatile("" : "+v"(t)); return t; }
DI u32x4 ld16_coh(const void* p) { const unsigned long long a = __hip_atomic_load((const unsigned long long*)p, __ATOMIC_RELAXED, __HIP_MEMORY_SCOPE_AGENT), b = __hip_atomic_load((const unsigned long long*)p + 1, __ATOMIC_RELAXED, __HIP_MEMORY_SCOPE_AGENT);
    u32x4 r; r.x = (unsigned)a; r.y = (unsigned)(a >> 32); r.z = (unsigned)b; r.w = (unsigned)(b >> 32); return r; }
struct KArgs { const float* in[23]; float* out; unsigned char* ws; int run, pad1; };

enum { ACT_ID = 0, ACT_SILU = 1, ACT_LOG2F = 2, ACT_SCALE8 = 3, ACT_SIGM = 4, ACT_GELU = 5 };
struct Epi1 {
    static constexpr bool PERM = true, AFTER_DRAIN = false, HAS_MID = false;
    bf16_t* P; bf16_t* BR; float* MLG; const float* bias; const float* lb;
    DI void operator()(const f32x4 (&acc)[2][2][4][2], const pg8::Unit& u, int wr, int wc, int fr, int fq) const {
        const int pn = u.pn, row0 = u.pm * 256 + wr * 64 + fr;
        if (pn == 20) {
            if (wc == 0 && fq < 2) {
                const f32x4 b0 = *(const f32x4*)(bias + 5120 + 8 * fq), b1 = *(const f32x4*)(bias + 5120 + 8 * fq + 4);
#pragma unroll
                for (int ai = 0; ai < 2; ++ai)
#pragma unroll
                    for (int m = 0; m < 4; ++m) { float* dst = MLG + (size_t)(row0 + ai * 128 + m * 16) * 16 + 8 * fq;
                        *(f32x4*)dst = acc[ai][0][m][0] + b0; *(f32x4*)(dst + 4) = acc[ai][0][m][1] + b1; }
            }
            return;
        }
        int act, ldc, colt; bf16_t* base;
        if (pn < 14) { base = P; ldc = NP; colt = pn * 256; act = pn < 2 ? ACT_SILU : (pn < 4 ? ACT_ID : (pn < 8 ? ACT_LOG2F : (pn == 8 ? ACT_SCALE8 : ACT_ID))); }
        else { const int n = (pn - 14) >> 1; base = BR; ldc = 1536; colt = (pn - 14) * 256; act = n == 0 ? ACT_SILU : (n == 1 ? ACT_SIGM : ACT_GELU); }
        const int cin = wc * 32 + 8 * fq, bcol0 = pn * 256 + cin;
        bf16_t* tbase = base + (size_t)row0 * ldc + colt + cin;
        switch (act) {
            case ACT_SILU:   tile<ACT_SILU>(acc, tbase, ldc, bcol0); break;
            case ACT_LOG2F:  tile<ACT_LOG2F>(acc, tbase, ldc, bcol0); break;
            case ACT_SCALE8: tile<ACT_SCALE8>(acc, tbase, ldc, bcol0); break;
            case ACT_SIGM:   tile<ACT_SIGM>(acc, tbase, ldc, bcol0); break;
            case ACT_GELU:   tile<ACT_GELU>(acc, tbase, ldc, bcol0); break;
            default:         tile<ACT_ID>(acc, tbase, ldc, bcol0); break;
        }
    }
    template <int ACT> DI void tile(const f32x4 (&acc)[2][2][4][2], bf16_t* tbase, int ldc, int bcol0) const {
        f32x4 bv[2][2], lbv[2][2];
#pragma unroll
        for (int bj = 0; bj < 2; ++bj)
#pragma unroll
            for (int n = 0; n < 2; ++n) { bv[bj][n] = *(const f32x4*)(bias + bcol0 + bj * 128 + 4 * n);
                lbv[bj][n] = (ACT == ACT_LOG2F) ? *(const f32x4*)(lb + (bcol0 - 1024) + bj * 128 + 4 * n) : (f32x4){0.f, 0.f, 0.f, 0.f}; }
#pragma unroll
        for (int ai = 0; ai < 2; ++ai)
#pragma unroll
            for (int m = 0; m < 4; ++m) { bf16_t* rowp = tbase + (size_t)(ai * 128 + m * 16) * ldc;
#pragma unroll
                for (int bj = 0; bj < 2; ++bj) { f32x4 v[2];
#pragma unroll
                    for (int n = 0; n < 2; ++n) { v[n] = acc[ai][bj][m][n] + bv[bj][n];
#pragma unroll
                        for (int j = 0; j < 4; ++j) { float x = v[n][j];
                            if (ACT == ACT_SILU) x = silu_(x);
                            else if (ACT == ACT_LOG2F) { const float l = lbv[bj][n][j]; x = lg2(l + (1.f - l) * sigm(x)); }
                            else if (ACT == ACT_SCALE8) x *= 0.125f;
                            else if (ACT == ACT_SIGM) x = sigm(x);
                            else if (ACT == ACT_GELU) x = gelu_t(x);
                            v[n][j] = x; } }
                    u32x4 w; w.x = pk2(v[0][0], v[0][1]); w.y = pk2(v[0][2], v[0][3]); w.z = pk2(v[1][0], v[1][1]); w.w = pk2(v[1][2], v[1][3]);
                    *(u32x4*)(rowp + bj * 128) = w; } }
    }
};
struct Epi2 {
    static constexpr bool PERM = true, AFTER_DRAIN = false, HAS_MID = false;
    bf16_t* G; const float* bias;
    DI void operator()(const f32x4 (&acc)[2][2][4][2], const pg8::Unit& u, int wr, int wc, int fr, int fq) const {
        const int row0 = u.pm * 256 + wr * 64 + fr, col0 = u.pn * 256 + wc * 32 + 8 * fq;
        f32x4 bv[2][2];
#pragma unroll
        for (int bj = 0; bj < 2; ++bj)
#pragma unroll
            for (int n = 0; n < 2; ++n) bv[bj][n] = *(const f32x4*)(bias + col0 + bj * 128 + 4 * n);
#pragma unroll
        for (int ai = 0; ai < 2; ++ai)
#pragma unroll
            for (int m = 0; m < 4; ++m) { bf16_t* rowp = G + (size_t)(row0 + ai * 128 + m * 16) * NG + col0;
#pragma unroll
                for (int bj = 0; bj < 2; ++bj) { f32x4 v0 = acc[ai][bj][m][0] + bv[bj][0], v1 = acc[ai][bj][m][1] + bv[bj][1];
#pragma unroll
                    for (int j = 0; j < 4; ++j) { v0[j] = sigm(v0[j]); v1[j] = sigm(v1[j]); }
                    u32x4 w; w.x = pk2(v0[0], v0[1]); w.y = pk2(v0[2], v0[3]); w.z = pk2(v1[0], v1[1]); w.w = pk2(v1[2], v1[3]);
                    *(u32x4*)(rowp + bj * 128) = w; } }
    }
};
struct Epi3 {
    static constexpr bool PERM = true, AFTER_DRAIN = false, HAS_MID = true;
    const bf16_t* G; bf16_t* MG;
    DI void mid(f32x4 (&acc)[2][2][4][2], const pg8::Unit& u, int nb, int wr, int wc, int fr, int fq) const {
        int row0 = u.pm * 256 + wr * 64 + fr, col0 = u.pn * 256 + wc * 32 + 8 * fq;
        asm volatile("" : "+v"(row0), "+v"(col0));
#pragma unroll
        for (int ai = 0; ai < 2; ++ai)
#pragma unroll
            for (int mp = 0; mp < 1; ++mp) { u32x4 ga[4][2], gb[4][2];
#pragma unroll
                for (int mm = 0; mm < 4; ++mm) { const size_t r = (size_t)(row0 + ai * 128 + (4 * mp + mm) * 16);
#pragma unroll
                    for (int bj = 0; bj < 2; ++bj) { ga[mm][bj] = *(const u32x4*)(G + r * NG + (nb - 1) * 1024 + col0 + bj * 128); gb[mm][bj] = *(const u32x4*)(G + r * NG + nb * 1024 + col0 + bj * 128); } }
#pragma unroll
                for (int mm = 0; mm < 4; ++mm) { const int m = 4 * mp + mm;
#pragma unroll
                    for (int bj = 0; bj < 2; ++bj) { const u32x4 a = ga[mm][bj], bq = gb[mm][bj];
                        f32x4 a0 = acc[ai][bj][m][0], a1 = acc[ai][bj][m][1];
                        a0[0] *= bflo(a.x) * rcpf_(bflo(bq.x)); a0[1] *= bfhi(a.x) * rcpf_(bfhi(bq.x)); a0[2] *= bflo(a.y) * rcpf_(bflo(bq.y)); a0[3] *= bfhi(a.y) * rcpf_(bfhi(bq.y));
                        a1[0] *= bflo(a.z) * rcpf_(bflo(bq.z)); a1[1] *= bfhi(a.z) * rcpf_(bfhi(bq.z)); a1[2] *= bflo(a.w) * rcpf_(bflo(bq.w)); a1[3] *= bfhi(a.w) * rcpf_(bfhi(bq.w));
                        acc[ai][bj][m][0] = a0; acc[ai][bj][m][1] = a1; } }
                asm volatile("" ::: "memory"); }
    }
    DI void operator()(const f32x4 (&acc)[2][2][4][2], const pg8::Unit& u, int wr, int wc, int fr, int fq) const {
        const int row0 = u.pm * 256 + wr * 64 + fr, col0 = u.pn * 256 + wc * 32 + 8 * fq;
#pragma unroll
        for (int ai = 0; ai < 2; ++ai) { u32x4 gws[4][2];
#pragma unroll
            for (int m = 0; m < 4; ++m)
#pragma unroll
                for (int bj = 0; bj < 2; ++bj) gws[m][bj] = *(const u32x4*)(G + (size_t)(row0 + ai * 128 + m * 16) * NG + 2 * 1024 + col0 + bj * 128);
#pragma unroll
            for (int m = 0; m < 4; ++m) { const size_t r = (size_t)(row0 + ai * 128 + m * 16);
#pragma unroll
                for (int bj = 0; bj < 2; ++bj) { const u32x4 gw = gws[m][bj];
                    const f32x4 a0 = acc[ai][bj][m][0], a1 = acc[ai][bj][m][1];
                    u32x4 w; w.x = pk2(bflo(gw.x) * a0[0], bfhi(gw.x) * a0[1]); w.y = pk2(bflo(gw.y) * a0[2], bfhi(gw.y) * a0[3]); w.z = pk2(bflo(gw.z) * a1[0], bfhi(gw.z) * a1[1]); w.w = pk2(bflo(gw.w) * a1[2], bfhi(gw.w) * a1[3]);
                    *(u32x4*)(MG + r * 1024 + col0 + bj * 128) = w; } }
            asm volatile("" ::: "memory"); }
    }
};
struct EpiRes {
    static constexpr bool PERM = false, AFTER_DRAIN = false, HAS_MID = false;
    const float* xsrc; float* xdst; const float* csrc; float* cdst; const float* mod; int colmajor; float pscale; int b;
    DI void operator()(const f32x4 (&acc)[2][2][4][2], const pg8::Unit& u, int wr, int wc, int fr, int fq) const {
        const int rowt = u.pm * 256; const bool isx = rowt < 4096; const int bb = isx ? b : 8;
        const float* mrow = mod + bb * 6144; const int col0 = u.pn * 256 + wc * 32 + 4 * fq;
        f32x4 mv[2][2];
#pragma unroll
        for (int bj = 0; bj < 2; ++bj)
#pragma unroll
            for (int n = 0; n < 2; ++n) mv[bj][n] = *(const f32x4*)(mrow + col0 + bj * 128 + n * 16) * pscale;
#pragma unroll
        for (int ai = 0; ai < 2; ++ai)
#pragma unroll
            for (int mp = 0; mp < 1; ++mp) { const float* src[4]; float* dst[4]; f32x4 xin[4][2][2];
#pragma unroll
                for (int mm = 0; mm < 4; ++mm) { const int m = 4 * mp + mm; const int r = rowt + ai * 128 + wr * 64 + m * 16 + fr;
                    if (isx) { const int p = r; const int t = colmajor ? (((p & 63) << 6) | (p >> 6)) : p; const size_t off = ((size_t)(b * 4096 + t)) * 1024 + col0; src[mm] = xsrc + off; dst[mm] = xdst + off; }
                    else { const size_t off = (size_t)(b * 256 + (r - 4096)) * 1024 + col0; src[mm] = csrc + off; dst[mm] = cdst + off; }
#pragma unroll
                    for (int bj = 0; bj < 2; ++bj)
#pragma unroll
                        for (int n = 0; n < 2; ++n) xin[mm][bj][n] = *(const f32x4*)(src[mm] + bj * 128 + n * 16); }
#pragma unroll
                for (int mm = 0; mm < 4; ++mm) { const int m = 4 * mp + mm;
#pragma unroll
                    for (int bj = 0; bj < 2; ++bj)
#pragma unroll
                        for (int n = 0; n < 2; ++n) *(f32x4*)(dst[mm] + bj * 128 + n * 16) = xin[mm][bj][n] + mv[bj][n] * acc[ai][bj][m][n]; }
                asm volatile("" ::: "memory"); }
    }
};
struct Epi5 {
    static constexpr bool PERM = true, AFTER_DRAIN = false, HAS_MID = false;
    bf16_t* H;
    DI void operator()(const f32x4 (&acc)[2][2][4][2], const pg8::Unit& u, int wr, int wc, int fr, int fq) const {
        const int row0 = u.pm * 256 + wr * 64 + fr, col0 = u.pn * 128 + wc * 32 + 8 * fq;
#pragma unroll
        for (int ai = 0; ai < 2; ++ai)
#pragma unroll
            for (int m = 0; m < 4; ++m) { bf16_t* rowp = H + (size_t)(row0 + ai * 128 + m * 16) * FF + col0;
                f32x4 v0, v1;
#pragma unroll
                for (int j = 0; j < 4; ++j) { v0[j] = silu_(acc[ai][0][m][0][j]) * acc[ai][1][m][0][j]; v1[j] = silu_(acc[ai][0][m][1][j]) * acc[ai][1][m][1][j]; }
                u32x4 w; w.x = pk2(v0[0], v0[1]); w.y = pk2(v0[2], v0[3]); w.z = pk2(v1[0], v1[1]); w.w = pk2(v1[2], v1[3]);
                *(u32x4*)rowp = w; }
    }
};
template <class Epi> DI void run_gemm(LAS unsigned char* lds, const bf16_t* A, const bf16_t* Bt, int M, int N, int K, const Epi& E, int gr, int gs) {
    pg8::Gemm g{A, Bt, M, N, K}; pg8::StaticOrder S; S.init(M, N, gs, gr);
    pg8::gemm_phase<Epi, pg8::StaticOrder, PG8_ALIGN_V, PG8_SP2_V>(lds, g, S, E);
}

DI void phase_mod(const KArgs& a, LAS unsigned char* lds, float* MOD, float* LB) {
    LAS float* SC = (LAS float*)lds; LAS float* RED = SC + 9 * 1024;
    const int tid = otid(), lane = tid & 63, w = tid >> 6;
    for (int i = tid; i < 9 * 1024; i += 512) { const int r = i >> 10, k = i & 1023; const float v = r < 8 ? a.in[1][r * 1024 + k] : a.in[3][k]; SC[i] = v / (1.f + __expf(-v)); }
    __syncthreads();
    for (int u = blockIdx.x; u < 4 * 96; u += gridDim.x) {
        const int l = u / 96, n0 = (u % 96) * 64;
        const float* W = a.in[4] + (size_t)l * 1024 * 6144 + n0 + lane;
        float acc[9];
#pragma unroll
        for (int r = 0; r < 9; ++r) acc[r] = 0.f;
#pragma unroll 16
        for (int k = w * 128; k < w * 128 + 128; ++k) { const float wv = W[(size_t)k * 6144];
#pragma unroll
            for (int r = 0; r < 9; ++r) acc[r] += SC[r * 1024 + k] * wv; }
#pragma unroll
        for (int r = 0; r < 9; ++r) RED[(w * 9 + r) * 64 + lane] = acc[r];
        __syncthreads();
        for (int i = tid; i < 9 * 64; i += 512) { const int r = i >> 6, c = i & 63; float s = 0.f;
#pragma unroll
            for (int ww = 0; ww < 8; ++ww) s += RED[(ww * 9 + r) * 64 + c];
            MOD[((size_t)l * 9 + r) * 6144 + n0 + c] = s + a.in[5][l * 6144 + n0 + c]; }
        __syncthreads();
    }
    for (int i = blockIdx.x * 512 + tid; i < 1024; i += gridDim.x * 512) {
        const float r0 = a.in[9][i], r1 = a.in[9][1024 + i], r2 = a.in[9][2048 + i], r3 = a.in[9][3072 + i];
        const float mx = fmaxf(fmaxf(r0, r1), fmaxf(r2, r3));
        const float e0 = __expf(r0 - mx), e1 = __expf(r1 - mx), e2 = __expf(r2 - mx), e3 = __expf(r3 - mx), inv = 1.f / (e0 + e1 + e2 + e3);
        LB[i] = 0.f; LB[1024 + i] = e1 * inv; LB[2048 + i] = (e1 + e2) * inv; LB[3072 + i] = (e1 + e2 + e3) * inv;
    }
}
DI int map_in(int n) {
    if (n < 1024) return n;
    if (n < 1536) return 3584 + (n - 1024);
    if (n < 2560) return 1024 + (n - 1536);
    if (n < 2816) return 2048 + (n - 2560);
    if (n < 3072) return 2304 + (n - 2816);
    if (n < 3584) return 2560 + (n - 3072);
    if (n < 4096) return 4096 + (n - 3584);
    if (n < 4112) return 5120 + (n - 4096);
    if (n < 4624) return 3072 + (n - 4112);
    if (n < 5136) return 4608 + (n - 4624);
    return 5376 + (n - 5136);
}
DI int map_ffn(int n) { return n < FF ? ((n >> 7) * 256 + (n & 127)) : (((n - FF) >> 7) * 256 + 128 + ((n - FF) & 127)); }
template <int MAP> DI void conv_item(const float* W, int K, int N, bf16_t* WT, LAS float* scr, int item, int lane, int ldk = 0) {
    if (ldk == 0) ldk = K;
    const int nblk = (N + 31) / 32, kb = item / nblk, nb = item % nblk, k0 = 64 * kb, n0 = 32 * nb;
    const int nn = n0 + (lane & 31); const bool ok = nn < N;
#pragma unroll 8
    for (int i = 0; i < 32; ++i) { const int kk = 2 * i + (lane >> 5); scr[kk * 33 + (lane & 31)] = ok ? W[(size_t)(k0 + kk) * N + nn] : 0.f; }
    asm volatile("s_waitcnt lgkmcnt(0)" ::: "memory");
    const int c = lane & 7;
#pragma unroll
    for (int j = 0; j < 4; ++j) { const int nl = (lane >> 3) + 8 * j, n = n0 + nl;
        if (n < N) { const LAS float* s = scr + (8 * c) * 33 + nl;
            u32x4 o; o.x = pk2(s[0 * 33], s[1 * 33]); o.y = pk2(s[2 * 33], s[3 * 33]); o.z = pk2(s[4 * 33], s[5 * 33]); o.w = pk2(s[6 * 33], s[7 * 33]);
            const int dr = MAP == 1 ? map_in(n) : (MAP == 2 ? map_ffn(n) : n);
            *(u32x4*)(WT + (size_t)dr * ldk + k0 + 8 * c) = o; } }
    asm volatile("s_waitcnt lgkmcnt(0)" ::: "memory");
}
DI void phase_conv(const KArgs& a, LAS unsigned char* lds, int l, unsigned char* wsw, float* BIAS) {
    const int tid = otid(), lane = tid & 63, w = tid >> 6;
    LAS float* scr = (LAS float*)(lds + w * 16384);
    const int gw = blockIdx.x * 8 + w, NGW = gridDim.x * 8;
    constexpr int I_IN = 16 * 257, I_BR = 8 * 32, I_O = 16 * 32, I_FI = 16 * 176, I_FO = 44 * 32;
    constexpr int NIT = I_IN + 3 * I_BR + I_O + I_FI + I_FO;
    for (int it = gw; it < NIT; it += NGW) {
        int r = it;
        if (r < I_IN) { conv_item<1>(a.in[7] + (size_t)l * 1024 * NIN, 1024, NIN, (bf16_t*)(wsw + W_W1), scr, r, lane); continue; } r -= I_IN;
        if (r < 3 * I_BR) { const int n = r / I_BR; conv_item<0>(a.in[17] + ((size_t)l * 3 + n) * 512 * 1024, 512, 1024, (bf16_t*)(wsw + W_BR) + (size_t)n * 512, scr, r % I_BR, lane, 1536); continue; } r -= 3 * I_BR;
        if (r < I_O) { conv_item<0>(a.in[18] + (size_t)l * 1024 * 1024, 1024, 1024, (bf16_t*)(wsw + W_O), scr, r, lane); continue; } r -= I_O;
        if (r < I_FI) { conv_item<2>(a.in[20] + (size_t)l * 1024 * 2 * FF, 1024, 2 * FF, (bf16_t*)(wsw + W_FI), scr, r, lane); continue; } r -= I_FI;
        conv_item<0>(a.in[21] + (size_t)l * FF * 1024, FF, 1024, (bf16_t*)(wsw + W_FO), scr, r, lane);
    }
    for (int i = blockIdx.x * 512 + tid; i < NIN; i += gridDim.x * 512) BIAS[(size_t)l * NW1 + map_in(i)] = a.in[8][(size_t)l * NIN + i];
    for (int i = blockIdx.x * 512 + tid; i < 240; i += gridDim.x * 512) BIAS[(size_t)l * NW1 + 5136 + i] = 0.f;
}
DI void phase_conv_q(const KArgs& a, LAS unsigned char* lds, int l, unsigned char* wsw, float* BIAS, unsigned* q) {
    const int tid = otid(), lane = tid & 63, w = tid >> 6;
    LAS float* scr = (LAS float*)(lds + w * 16384);
    constexpr int I_IN = 16 * 257, I_BR = 8 * 32, I_O = 16 * 32, I_FI = 16 * 176, I_FO = 44 * 32;
    constexpr int NIT = I_IN + 3 * I_BR + I_O + I_FI + I_FO;
    for (;;) {
        unsigned itv = 0u; if (lane == 0) itv = __hip_atomic_fetch_add(q, 1u, __ATOMIC_RELAXED, __HIP_MEMORY_SCOPE_AGENT);
        const int it = __builtin_amdgcn_readfirstlane((int)itv);
        if (it >= NIT + 18) break;
        int r = it;
        if (r >= NIT) { r -= NIT;
            if (r < 17) {
#pragma unroll
                for (int k = 0; k < 8; ++k) { const int i = r * 512 + k * 64 + lane; if (i < NIN) BIAS[(size_t)l * NW1 + map_in(i)] = a.in[8][(size_t)l * NIN + i]; } }
            else {
#pragma unroll
                for (int k = 0; k < 4; ++k) { const int i = k * 64 + lane; if (i < 240) BIAS[(size_t)l * NW1 + 5136 + i] = 0.f; } }
            continue; }
        if (r < I_IN) { conv_item<1>(a.in[7] + (size_t)l * 1024 * NIN, 1024, NIN, (bf16_t*)(wsw + W_W1), scr, r, lane); continue; } r -= I_IN;
        if (r < 3 * I_BR) { const int n = r / I_BR; conv_item<0>(a.in[17] + ((size_t)l * 3 + n) * 512 * 1024, 512, 1024, (bf16_t*)(wsw + W_BR) + (size_t)n * 512, scr, r % I_BR, lane, 1536); continue; } r -= 3 * I_BR;
        if (r < I_O) { conv_item<0>(a.in[18] + (size_t)l * 1024 * 1024, 1024, 1024, (bf16_t*)(wsw + W_O), scr, r, lane); continue; } r -= I_O;
        if (r < I_FI) { conv_item<2>(a.in[20] + (size_t)l * 1024 * 2 * FF, 1024, 2 * FF, (bf16_t*)(wsw + W_FI), scr, r, lane); continue; } r -= I_FI;
        conv_item<0>(a.in[21] + (size_t)l * FF * 1024, FF, 1024, (bf16_t*)(wsw + W_FO), scr, r, lane);
    }
}
DI void norm_row(const float* src, const float* lnw, const float* shift, const float* scale, bf16_t* dst, int lane) {
    const f32x4* xr = (const f32x4*)src + lane; f32x4 v[4]; float s = 0.f;
#pragma unroll
    for (int j = 0; j < 4; ++j) { v[j] = xr[64 * j]; s += (v[j].x * v[j].x + v[j].y * v[j].y) + (v[j].z * v[j].z + v[j].w * v[j].w); }
    const float rstd = rsqrtf(wave_sum(s) * (1.f / D) + EPS);
#pragma unroll
    for (int j = 0; j < 4; ++j) { const int c = 4 * lane + 256 * j; const f32x4 w = *(const f32x4*)(lnw + c), sh = *(const f32x4*)(shift + c), sc = *(const f32x4*)(scale + c);
        const f32x4 y = v[j] * rstd * w * (sc + 1.f) + sh; u32x2 o; o.x = pk2(y.x, y.y); o.y = pk2(y.z, y.w); *(u32x2*)(dst + c) = o; }
}
DI const float* src_row(int m, int b, const float* xs, const float* cs, int colmajor, int& modrow) {
    if (m < 4096) { const int p = m, t = colmajor ? (((p & 63) << 6) | (p >> 6)) : p; modrow = b; return xs + ((size_t)(b * 4096 + t)) * 1024; }
    modrow = 8; return cs + (size_t)(b * 256 + (m - 4096)) * 1024;
}
DI void phase_norm(const float* xs, const float* cs, const float* lnw, const float* modl, int ksh, int ksc, int colmajor, bf16_t* AS, int Mrows, int b, int gr, int gs) {
    const int tid = otid(); const int lane = tid & 63, gw = gr * 8 + (tid >> 6), NGW = gs * 8;
    f32x4 wf[4], sf[4], nv[4]; int curmr = -1; int m = gw;
    if (m < Mrows) { int mr; const f32x4* xr = (const f32x4*)src_row(m, b, xs, cs, colmajor, mr) + lane;
#pragma unroll
        for (int j = 0; j < 4; ++j) nv[j] = xr[64 * j]; }
    while (m < Mrows) {
        f32x4 v[4];
#pragma unroll
        for (int j = 0; j < 4; ++j) v[j] = nv[j];
        const int mr = (m < 4096) ? b : 8, mn = m + NGW;
        if (mn < Mrows) { int mr2; const f32x4* xr = (const f32x4*)src_row(mn, b, xs, cs, colmajor, mr2) + lane;
#pragma unroll
            for (int j = 0; j < 4; ++j) nv[j] = xr[64 * j]; }
        if (mr != curmr) { curmr = mr;
#pragma unroll
            for (int j = 0; j < 4; ++j) { const int c = 4 * lane + 256 * j; wf[j] = *(const f32x4*)(lnw + c) * (*(const f32x4*)(modl + mr * 6144 + ksc * 1024 + c) + 1.f); sf[j] = *(const f32x4*)(modl + mr * 6144 + ksh * 1024 + c); } }
        float s = 0.f;
#pragma unroll
        for (int j = 0; j < 4; ++j) s += (v[j].x * v[j].x + v[j].y * v[j].y) + (v[j].z * v[j].z + v[j].w * v[j].w);
        const float rstd = rsqrtf(wave_sum(s) * (1.f / D) + EPS);
        bf16_t* dst = AS + (size_t)m * 1024;
#pragma unroll
        for (int j = 0; j < 4; ++j) { const f32x4 y = v[j] * rstd * wf[j] + sf[j]; u32x2 o; o.x = pk2(y.x, y.y); o.y = pk2(y.z, y.w); *(u32x2*)(dst + 4 * lane + 256 * j) = o; }
        m = mn;
    }
}
DI void phase_fin(const float* xs, const float* cs, const float* lnw, const float* modl, int colmajor, bf16_t* AS, bf16_t* SL, bf16_t* BR, const float* hgn, const float* mln, int Mrows, int b, int gr, int gs) {
    const int tid = otid(); const int lane = tid & 63, gw = gr * 8 + (tid >> 6), NGW = gs * 8;
    const int cb = (16 * lane) & 511; const float* nwp = (lane < 32 ? hgn : mln) + cb;
    f32x4 nw4[4];
#pragma unroll
    for (int j = 0; j < 4; ++j) nw4[j] = *(const f32x4*)(nwp + 4 * j);
    f32x4 wf[4], sf[4]; int curmr = -1; int m = gw;
    u32x4 ns0, ns1, ng0, ng1, nsl, ng2; f32x4 nv[4];
#define FIN_LOAD(mm) do { const bf16_t* ap = AS + (size_t)(mm) * 1024 + 16 * lane; ns0 = *(const u32x4*)ap; ns1 = *(const u32x4*)(ap + 8); const bf16_t* gp_ = BR + (size_t)(mm) * 1536 + 16 * lane; ng0 = *(const u32x4*)gp_; ng1 = *(const u32x4*)(gp_ + 8); \
        nsl = *(const u32x4*)(SL + (size_t)(mm) * 512 + 8 * lane); ng2 = *(const u32x4*)(BR + (size_t)(mm) * 1536 + 1024 + 8 * lane); \
        int mr_; const f32x4* xr = (const f32x4*)src_row((mm), b, xs, cs, colmajor, mr_) + lane; _Pragma("unroll") for (int j = 0; j < 4; ++j) nv[j] = xr[64 * j]; } while (0)
    if (m < Mrows) FIN_LOAD(m);
    while (m < Mrows) {
        const u32x4 s0 = ns0, s1 = ns1, g0 = ng0, g1 = ng1, sl = nsl, g2 = ng2; f32x4 v[4];
#pragma unroll
        for (int j = 0; j < 4; ++j) v[j] = nv[j];
        const int mr = (m < 4096) ? b : 8, mn = m + NGW;
        if (mn < Mrows) FIN_LOAD(mn);
        if (mr != curmr) { curmr = mr;
#pragma unroll
            for (int j = 0; j < 4; ++j) { const int c = 4 * lane + 256 * j; wf[j] = *(const f32x4*)(lnw + c) * (*(const f32x4*)(modl + mr * 6144 + 1024 + c) + 1.f); sf[j] = *(const f32x4*)(modl + mr * 6144 + c); } }
        {
            float sv[16] = { bflo(s0.x), bfhi(s0.x), bflo(s0.y), bfhi(s0.y), bflo(s0.z), bfhi(s0.z), bflo(s0.w), bfhi(s0.w), bflo(s1.x), bfhi(s1.x), bflo(s1.y), bfhi(s1.y), bflo(s1.z), bfhi(s1.z), bflo(s1.w), bfhi(s1.w) };
            float ss = 0.f;
#pragma unroll
            for (int j = 0; j < 16; ++j) ss += sv[j] * sv[j];
            ss += __shfl_xor(ss, 1); ss += __shfl_xor(ss, 2); ss += __shfl_xor(ss, 4);
            const float rstd = rsqrtf(ss * (1.f / 128.f) + EPS);
            const float g[16] = { bflo(g0.x), bfhi(g0.x), bflo(g0.y), bfhi(g0.y), bflo(g0.z), bfhi(g0.z), bflo(g0.w), bfhi(g0.w), bflo(g1.x), bfhi(g1.x), bflo(g1.y), bfhi(g1.y), bflo(g1.z), bfhi(g1.z), bflo(g1.w), bfhi(g1.w) };
            float o[16];
#pragma unroll
            for (int j = 0; j < 16; ++j) o[j] = sv[j] * rstd * nw4[j >> 2][j & 3] * g[j];
            u32x4 w0, w1; w0.x = pk2(o[0], o[1]); w0.y = pk2(o[2], o[3]); w0.z = pk2(o[4], o[5]); w0.w = pk2(o[6], o[7]); w1.x = pk2(o[8], o[9]); w1.y = pk2(o[10], o[11]); w1.z = pk2(o[12], o[13]); w1.w = pk2(o[14], o[15]);
            bf16_t* gp = BR + (size_t)m * 1536 + 16 * lane; ((u32x4*)gp)[0] = w0; ((u32x4*)gp)[1] = w1;
        }
        {
            u32x4 w; w.x = pk2(bflo(sl.x) * bflo(g2.x), bfhi(sl.x) * bfhi(g2.x)); w.y = pk2(bflo(sl.y) * bflo(g2.y), bfhi(sl.y) * bfhi(g2.y)); w.z = pk2(bflo(sl.z) * bflo(g2.z), bfhi(sl.z) * bfhi(g2.z)); w.w = pk2(bflo(sl.w) * bflo(g2.w), bfhi(sl.w) * bfhi(g2.w));
            *(u32x4*)(BR + (size_t)m * 1536 + 1024 + 8 * lane) = w;
        }
        {
            float s = 0.f;
#pragma unroll
            for (int j = 0; j < 4; ++j) s += (v[j].x * v[j].x + v[j].y * v[j].y) + (v[j].z * v[j].z + v[j].w * v[j].w);
            const float rstd = rsqrtf(wave_sum(s) * (1.f / D) + EPS);
            bf16_t* dst = AS + (size_t)m * 1024;
#pragma unroll
            for (int j = 0; j < 4; ++j) { const f32x4 y = v[j] * rstd * wf[j] + sf[j]; u32x2 o2; o2.x = pk2(y.x, y.y); o2.y = pk2(y.z, y.w); *(u32x2*)(dst + 4 * lane + 256 * j) = o2; }
        }
        m = mn;
    }
#undef FIN_LOAD
}
DI void phase_final(float* out, const float* fw, int gr, int gs) {
    const int tid = otid(); const int lane = tid & 63, gw = gr * 8 + (tid >> 6), NGW = gs * 8;
    f32x4 wv[4], nv[4];
#pragma unroll
    for (int j = 0; j < 4; ++j) wv[j] = *(const f32x4*)(fw + 4 * lane + 256 * j);
    int m = gw;
    if (m < 4096) { const f32x4* xr = (const f32x4*)(out + (size_t)m * 1024) + lane;
#pragma unroll
        for (int j = 0; j < 4; ++j) nv[j] = xr[64 * j]; }
    while (m < 4096) { f32x4 v[4]; float s = 0.f;
#pragma unroll
        for (int j = 0; j < 4; ++j) { v[j] = nv[j]; s += (v[j].x * v[j].x + v[j].y * v[j].y) + (v[j].z * v[j].z + v[j].w * v[j].w); }
        const int mn = m + NGW;
        if (mn < 4096) { const f32x4* xr = (const f32x4*)(out + (size_t)mn * 1024) + lane;
#pragma unroll
            for (int j = 0; j < 4; ++j) nv[j] = xr[64 * j]; }
        const float rstd = rsqrtf(wave_sum(s) * (1.f / D) + EPS);
        f32x4* xo = (f32x4*)(out + (size_t)m * 1024) + lane;
#pragma unroll
        for (int j = 0; j < 4; ++j) xo[64 * j] = v[j] * rstd * wv[j];
        m = mn; }
}

struct ScanArgs { const bf16_t* P; const float* MLG; bf16_t* AS; bf16_t* SL; const float* convw; const float* convb; const float* gw; const float* gb; const float* lam; int last; };
DI void chunk_geom(int j, int b, int dir, int& rowbase, int& pos0, int& slen, bool& first, bool& isx) {
    isx = j >= 4; const int cj = isx ? j - 4 : j, nch = isx ? 64 : 4, pc = dir ? nch - 1 - cj : cj;
    pos0 = pc * 64; slen = nch * 64; rowbase = (isx ? 0 : 4096) + pc * 64; first = cj < nch / 2; (void)b;
}
DI void out_rmw4(bf16_t* p, f32x4 v, bool first) {
    if (!first) { const unsigned long long w = __hip_atomic_load((unsigned long long*)p, __ATOMIC_RELAXED, __HIP_MEMORY_SCOPE_AGENT); const unsigned lo = (unsigned)w, hi = (unsigned)(w >> 32);
        v[0] += bflo(lo); v[1] += bfhi(lo); v[2] += bflo(hi); v[3] += bfhi(hi); }
    u32x2 o; o.x = pk2(v[0], v[1]); o.y = pk2(v[2], v[3]); *(u32x2*)p = o;
}
DI unsigned long long ld8_coh(const bf16_t* p) { return __hip_atomic_load((const unsigned long long*)p, __ATOMIC_RELAXED, __HIP_MEMORY_SCOPE_AGENT); }
DI void out_put4(bf16_t* p, f32x4 v, int mode, unsigned long long pre) {
    if (mode != 0) { const unsigned long long w = pre; const unsigned lo = (unsigned)w, hi = (unsigned)(w >> 32);
        v[0] += bflo(lo); v[1] += bfhi(lo); v[2] += bflo(hi); v[3] += bfhi(hi); }
    u32x2 o; o.x = pk2(v[0], v[1]); o.y = pk2(v[2], v[3]); *(u32x2*)p = o;
}
DI int pre_mode(bool first, int jn) { (void)jn; return first ? 0 : 1; }
DI bool late_pre(int jn) { return jn == 2 || jn == 36; }
constexpr int NSTEP = 68;
constexpr float ECLAMP = 120.f;

#define LBAR() do { asm volatile("s_waitcnt lgkmcnt(0)" ::: "memory"); __builtin_amdgcn_s_barrier(); asm volatile("" ::: "memory"); } while (0)
DI void scan_hgrn2(const ScanArgs& A, LAS unsigned char* lds, int unit) {
    const int tid = otid(), dir = tid >> 8, ht = tid & 255, hw = ht >> 6, lane = tid & 63, fr = lane & 15, fq = lane >> 4;
    const int b = 0, h = (unit >> 2) & 3, vs = unit & 3;
    LAS unsigned char* L = lds + dir * 76800;
    LAS bf16_t* Qt = (LAS bf16_t*)L;
    LAS bf16_t* Kt = Qt + 64 * 136;
    LAS bf16_t* KtT = Kt + 64 * 136;
    LAS bf16_t* Vt = KtT + 128 * 72;
    LAS bf16_t* Sc = Vt + 32 * 72;
    LAS bf16_t* Sb = Sc + 64 * 72;
    LAS float* GT = (LAS float*)Sc;
    LAS float* E2 = (LAS float*)(Sb + 32 * 136);
    LAS float* DEC = E2 + 128;
    const bf16_t* Pq = A.P + h * 128 + 2 * lane;
    const bf16_t* Pf = A.P + 1024 + dir * 512 + h * 128 + 2 * lane;
    const bf16_t* Pv = A.P + 512 + h * 128 + vs * 32 + (ht & 3) * 8;
    unsigned qw[16], fw[16]; u32x4 vv; unsigned long long pr[2] = {0ull, 0ull}; int pmode = 0;
    bf16_t* const opb = A.AS + h * 128 + vs * 32 + 4 * fq;
    f32x4 S[2][2];
#pragma unroll
    for (int a = 0; a < 2; ++a)
#pragma unroll
        for (int c = 0; c < 2; ++c) S[a][c] = (f32x4){0.f, 0.f, 0.f, 0.f};
    int rowbase, pos0, slen; bool first, isx;
    chunk_geom(0, b, dir, rowbase, pos0, slen, first, isx);
#define HG_LOAD() do { \
        _Pragma("unroll") for (int i = 0; i < 16; ++i) { const int t = 16 * hw + i; const size_t r = (size_t)(rowbase + (dir ? 63 - t : t)) * NP; qw[i] = *(const unsigned*)(Pq + r); fw[i] = *(const unsigned*)(Pf + r); } \
        { const int t = ht >> 2; vv = *(const u32x4*)(Pv + (size_t)(rowbase + (dir ? 63 - t : t)) * NP); } \
        if (pmode == 1 && !late_pre(jnx)) { const int t = 16 * hw + fr; const bf16_t* op = opb + (size_t)(rowbase + (dir ? 63 - t : t)) * 1024; pr[0] = ld8_coh(op); pr[1] = ld8_coh(op + 16); } } while (0)
    int jnx = 0;
    pmode = (A.last && !isx) ? 0 : pre_mode(first, 0);
    HG_LOAD();
    for (int j = 0; j < NSTEP; ++j) {
        const int orow = rowbase; const bool owrite = !(A.last && !isx); const int omode = pmode;
        if (late_pre(j) && pmode == 1) { const int t = 16 * hw + fr; const bf16_t* op = opb + (size_t)(rowbase + (dir ? 63 - t : t)) * 1024; pr[0] = ld8_coh(op); pr[1] = ld8_coh(op + 16); }
        unsigned long long opr0 = pr[0], opr1 = pr[1];
        asm volatile("" : "+v"(opr0), "+v"(opr1));
        float c0[16], c1[16]; float r0 = 0.f, r1 = 0.f;
#pragma unroll
        for (int i = 0; i < 16; ++i) { r0 += bflo(fw[i]); r1 += bfhi(fw[i]); c0[i] = r0; c1[i] = r1; }
        GT[hw * 128 + 2 * lane] = r0; GT[hw * 128 + 2 * lane + 1] = r1;
        { const int t = ht >> 2, v0 = (ht & 3) * 8; const unsigned vw[4] = {vv.x, vv.y, vv.z, vv.w};
#pragma unroll
            for (int e = 0; e < 4; ++e) { Vt[(v0 + 2 * e) * 72 + t] = (bf16_t)(vw[e] & 0xffffu); Vt[(v0 + 2 * e + 1) * 72 + t] = (bf16_t)(vw[e] >> 16); } }
        LBAR();
        {
            const float g00 = GT[2 * lane], g01 = GT[128 + 2 * lane], g02 = GT[256 + 2 * lane], g03 = GT[384 + 2 * lane];
            const float g10 = GT[2 * lane + 1], g11 = GT[128 + 2 * lane + 1], g12 = GT[256 + 2 * lane + 1], g13 = GT[384 + 2 * lane + 1];
            const float ref0 = g00 + g01, ref1 = g10 + g11, tot0 = ref0 + g02 + g03, tot1 = ref1 + g12 + g13;
            const float pre0 = hw == 0 ? 0.f : (hw == 1 ? g00 : (hw == 2 ? ref0 : ref0 + g02));
            const float pre1 = hw == 0 ? 0.f : (hw == 1 ? g10 : (hw == 2 ? ref1 : ref1 + g12));
            unsigned kp0[8], kp1[8];
            const float bs0 = fminf(fmaxf(pre0 - ref0, -ECLAMP), ECLAMP), bs1 = fminf(fmaxf(pre1 - ref1, -ECLAMP), ECLAMP);
            const float sq0 = ex2(bs0), sk0 = ex2(-bs0), sq1 = ex2(bs1), sk1 = ex2(-bs1);
            float E0 = 1.f, E1 = 1.f;
#pragma unroll
            for (int i = 0; i < 16; ++i) {
                const int t = 16 * hw + i;
                const float f0 = ex2(bflo(fw[i])), f1 = ex2(bfhi(fw[i]));
                E0 *= f0; E1 *= f1;
                const float eq0 = sq0 * E0, eq1 = sq1 * E1;
                const float ek0 = fminf(sk0 * rcpf_(E0), 1.3e36f), ek1 = fminf(sk1 * rcpf_(E1), 1.3e36f);
                const float q0 = bflo(qw[i]) * eq0, q1 = bfhi(qw[i]) * eq1;
                const float k0 = (1.f - f0) * ek0, k1 = (1.f - f1) * ek1;
                *(LAS unsigned*)(Qt + t * 136 + 2 * lane) = pk2(q0, q1);
                const unsigned kk = pk2(k0, k1);
                *(LAS unsigned*)(Kt + t * 136 + 2 * lane) = kk;
                if (i & 1) { kp0[i >> 1] |= (kk << 16); kp1[i >> 1] |= (kk & 0xffff0000u); } else { kp0[i >> 1] = kk & 0xffffu; kp1[i >> 1] = kk >> 16; }
            }
            { u32x4 w; w.x = kp0[0]; w.y = kp0[1]; w.z = kp0[2]; w.w = kp0[3]; *(LAS u32x4*)(KtT + (2 * lane) * 72 + 16 * hw) = w; w.x = kp0[4]; w.y = kp0[5]; w.z = kp0[6]; w.w = kp0[7]; *(LAS u32x4*)(KtT + (2 * lane) * 72 + 16 * hw + 8) = w;
              w.x = kp1[0]; w.y = kp1[1]; w.z = kp1[2]; w.w = kp1[3]; *(LAS u32x4*)(KtT + (2 * lane + 1) * 72 + 16 * hw) = w; w.x = kp1[4]; w.y = kp1[5]; w.z = kp1[6]; w.w = kp1[7]; *(LAS u32x4*)(KtT + (2 * lane + 1) * 72 + 16 * hw + 8) = w; }
            if (hw == 0) { E2[2 * lane] = ex2(tot0 - ref0); E2[2 * lane + 1] = ex2(tot1 - ref1); DEC[2 * lane] = ex2(tot0); DEC[2 * lane + 1] = ex2(tot1); }
#pragma unroll
            for (int a = 0; a < 2; ++a) { const int kb = 16 * (2 * hw + a) + 4 * fq; float sc4[4];
#pragma unroll
                for (int i = 0; i < 4; ++i) sc4[i] = ex2(GT[kb + i] + GT[128 + kb + i]);
#pragma unroll
                for (int c = 0; c < 2; ++c) { u32x2 w; w.x = pk2(S[a][c][0] * sc4[0], S[a][c][1] * sc4[1]); w.y = pk2(S[a][c][2] * sc4[2], S[a][c][3] * sc4[3]); *(LAS u32x2*)(Sb + (16 * c + fr) * 136 + kb) = w; } }
        }
        LBAR();
        if (j + 1 < NSTEP) { chunk_geom(j + 1, b, dir, rowbase, pos0, slen, first, isx); pmode = (A.last && !isx) ? 0 : pre_mode(first, j + 1); jnx = j + 1; HG_LOAD(); }
#pragma unroll
        for (int st = 0; st < 4; ++st) {
            f32x4 acc = (f32x4){0.f, 0.f, 0.f, 0.f};
            if (st <= hw) {
#pragma unroll
                for (int kk = 0; kk < 4; ++kk) acc = mfma16(ldfrag(Kt, 136, 16 * st, 32 * kk, lane), ldfrag(Qt, 136, 16 * hw, 32 * kk, lane), acc);
                if (st == hw) {
#pragma unroll
                    for (int i = 0; i < 4; ++i) acc[i] = (4 * fq + i <= fr) ? acc[i] : 0.f;
                }
            }
            u32x2 w; w.x = pk2(acc[0], acc[1]); w.y = pk2(acc[2], acc[3]);
            *(LAS u32x2*)(Sc + (16 * hw + fr) * 72 + 16 * st + 4 * fq) = w;
        }
        {
            const int t = 16 * hw + fr; bf16_t* op = opb + (size_t)(orow + (dir ? 63 - t : t)) * 1024;
#pragma unroll
            for (int c = 0; c < 2; ++c) { f32x4 acc = (f32x4){0.f, 0.f, 0.f, 0.f};
#pragma unroll
                for (int ks = 0; ks < 2; ++ks) acc = mfma16(ldfrag(Vt, 72, 16 * c, 32 * ks, lane), ldfrag(Sc, 72, 16 * hw, 32 * ks, lane), acc);
#pragma unroll
                for (int kk = 0; kk < 4; ++kk) acc = mfma16(ldfrag(Sb, 136, 16 * c, 32 * kk, lane), ldfrag(Qt, 136, 16 * hw, 32 * kk, lane), acc);
                if (owrite) out_put4(op + 16 * c, acc, omode, c == 0 ? opr0 : opr1); }
        }
#pragma unroll
        for (int a = 0; a < 2; ++a) { const int kb = 16 * (2 * hw + a);
            f32x4 dk, ek;
#pragma unroll
            for (int i = 0; i < 4; ++i) { dk[i] = DEC[kb + 4 * fq + i]; ek[i] = E2[kb + 4 * fq + i]; }
#pragma unroll
            for (int c = 0; c < 2; ++c) { f32x4 d = (f32x4){0.f, 0.f, 0.f, 0.f};
#pragma unroll
                for (int ks = 0; ks < 2; ++ks) d = mfma16(ldfrag(KtT, 72, kb, 32 * ks, lane), ldfrag(Vt, 72, 16 * c, 32 * ks, lane), d);
                S[a][c] = S[a][c] * dk + d * ek; } }
        if (j == 1 || j == 35) asm volatile("s_waitcnt vmcnt(0)" ::: "memory");
        LBAR();
    }
#undef HG_LOAD
}

DI void scan_mlstm(const ScanArgs& A, LAS unsigned char* lds, int unit) {
    const int tid = otid(), dir = tid >> 8, ht = tid & 255, hw = ht >> 6, lane = tid & 63, fr = lane & 15, fq = lane >> 4;
    const int b = 0, h = (unit >> 1) & 3, vs = unit & 1;
    LAS unsigned char* L = lds + dir * 63488;
    LAS bf16_t* Qs = (LAS bf16_t*)L;
    LAS bf16_t* Ks = Qs + 64 * 72;
    LAS bf16_t* KhT = Ks + 64 * 72;
    LAS bf16_t* Vt = KhT + 64 * 72;
    LAS bf16_t* Sc = Vt + 80 * 72;
    LAS bf16_t* Cb = Sc + 64 * 72;
    LAS float* G2 = (LAS float*)(Cb + 80 * 72);
    LAS float* M2 = G2 + 64; LAS float* WI = M2 + 64; LAS float* EM = WI + 64; LAS float* WS = EM + 64; LAS float* MISC = WS + 64;
    for (int i = ht; i < 16 * 72; i += 256) Vt[64 * 72 + i] = (i < 72) ? (bf16_t)0x3F80u : (bf16_t)0u;
    const int t_ld = ht >> 2, cg = ht & 3;
    const bf16_t* Pq = A.P + 2048 + h * 64 + cg * 16;
    const bf16_t* Pk = A.P + 2304 + h * 64 + cg * 16;
    const bf16_t* Pv = A.P + 2560 + h * 128 + vs * 64 + cg * 16;
    u32x4 rq[2], rk[2], rv[2]; float rig = 0.f, rfg = 0.f; unsigned long long pr[4] = {0ull, 0ull, 0ull, 0ull}; int pmode = 0;
    bf16_t* const opb = A.AS + 512 + h * 128 + vs * 64 + 4 * fq;
    f32x4 C[5];
#pragma unroll
    for (int c = 0; c < 5; ++c) C[c] = (f32x4){0.f, 0.f, 0.f, 0.f};
    float m2prev = 0.f;
    int rowbase, pos0, slen; bool first, isx;
    chunk_geom(0, b, dir, rowbase, pos0, slen, first, isx);
#define ML_LOAD() do { const size_t r = (size_t)(rowbase + (dir ? 63 - t_ld : t_ld)) * NP; \
        rq[0] = *(const u32x4*)(Pq + r); rq[1] = *(const u32x4*)(Pq + r + 8); rk[0] = *(const u32x4*)(Pk + r); rk[1] = *(const u32x4*)(Pk + r + 8); rv[0] = *(const u32x4*)(Pv + r); rv[1] = *(const u32x4*)(Pv + r + 8); \
        if (hw == 0) { const float* g = A.MLG + (size_t)(rowbase + (dir ? 63 - lane : lane)) * 16 + dir * 4 + h; rig = g[0]; rfg = g[8]; } \
        if (pmode == 1 && !late_pre(jnx)) { const int t = 16 * hw + fr; const bf16_t* op = opb + (size_t)(rowbase + (dir ? 63 - t : t)) * 1024; _Pragma("unroll") for (int c = 0; c < 4; ++c) pr[c] = ld8_coh(op + 16 * c); } } while (0)
    int jnx = 0;
    pmode = (A.last && !isx) ? 0 : pre_mode(first, 0);
    ML_LOAD();
    for (int j = 0; j < NSTEP; ++j) {
        const int orow = rowbase; const bool owrite = !(A.last && !isx); const int omode = pmode;
        if (late_pre(j) && pmode == 1) { const int t = 16 * hw + fr; const bf16_t* op = opb + (size_t)(rowbase + (dir ? 63 - t : t)) * 1024; _Pragma("unroll") for (int c = 0; c < 4; ++c) pr[c] = ld8_coh(op + 16 * c); }
        unsigned long long opr[4] = {pr[0], pr[1], pr[2], pr[3]};
        asm volatile("" : "+v"(opr[0]), "+v"(opr[1]), "+v"(opr[2]), "+v"(opr[3]));
#pragma unroll
        for (int c = 0; c < 5; ++c) { u32x2 w; w.x = pk2(C[c][0], C[c][1]); w.y = pk2(C[c][2], C[c][3]); *(LAS u32x2*)(Cb + (16 * c + fr) * 72 + 16 * hw + 4 * fq) = w; }
        *(LAS u32x4*)(Qs + t_ld * 72 + cg * 16) = rq[0]; *(LAS u32x4*)(Qs + t_ld * 72 + cg * 16 + 8) = rq[1];
        *(LAS u32x4*)(Ks + t_ld * 72 + cg * 16) = rk[0]; *(LAS u32x4*)(Ks + t_ld * 72 + cg * 16 + 8) = rk[1];
        { const unsigned vw[8] = {rv[0].x, rv[0].y, rv[0].z, rv[0].w, rv[1].x, rv[1].y, rv[1].z, rv[1].w};
#pragma unroll
            for (int e = 0; e < 8; ++e) { Vt[(cg * 16 + 2 * e) * 72 + t_ld] = (bf16_t)(vw[e] & 0xffffu); Vt[(cg * 16 + 2 * e + 1) * 72 + t_ld] = (bf16_t)(vw[e] >> 16); } }
        if (hw == 0) {
            const float i2 = rig * LOG2E, lf2 = -lg2(1.f + ex2(-rfg * LOG2E));
            float b2 = lf2;
#pragma unroll
            for (int o = 1; o < 64; o <<= 1) { const float y = __shfl_up(b2, o); if (lane >= o) b2 += y; }
            const float g2 = i2 - b2; float pm = g2;
#pragma unroll
            for (int o = 1; o < 64; o <<= 1) { const float y = __shfl_up(pm, o); if (lane >= o) pm = fmaxf(pm, y); }
            const float m2 = fmaxf(pm, m2prev);
            const float m63 = __shfl(m2, 63), b63 = __shfl(b2, 63);
            G2[lane] = g2; M2[lane] = m2; WI[lane] = ex2(m2prev - m2); EM[lane] = ex2(fminf(-(b2 + m2), ECLAMP)); WS[lane] = ex2(g2 - m63);
            if (lane == 0) MISC[0] = ex2(m2prev - m63);
            m2prev = b63 + m63;
        }
        LBAR();
        { const float ws = WS[t_ld]; const unsigned kw[8] = {rk[0].x, rk[0].y, rk[0].z, rk[0].w, rk[1].x, rk[1].y, rk[1].z, rk[1].w};
#pragma unroll
            for (int e = 0; e < 8; ++e) { const unsigned p = pk2(bflo(kw[e]) * ws, bfhi(kw[e]) * ws); KhT[(cg * 16 + 2 * e) * 72 + t_ld] = (bf16_t)(p & 0xffffu); KhT[(cg * 16 + 2 * e + 1) * 72 + t_ld] = (bf16_t)(p >> 16); } }
        LBAR();
        if (j + 1 < NSTEP) { chunk_geom(j + 1, b, dir, rowbase, pos0, slen, first, isx); pmode = (A.last && !isx) ? 0 : pre_mode(first, j + 1); jnx = j + 1; ML_LOAD(); }
        const int t = 16 * hw + fr; const float mt = M2[t];
#pragma unroll
        for (int st = 0; st < 4; ++st) {
            f32x4 acc = (f32x4){0.f, 0.f, 0.f, 0.f};
            if (st <= hw) {
#pragma unroll
                for (int kk = 0; kk < 2; ++kk) acc = mfma16(ldfrag(Ks, 72, 16 * st, 32 * kk, lane), ldfrag(Qs, 72, 16 * hw, 32 * kk, lane), acc);
#pragma unroll
                for (int i = 0; i < 4; ++i) { const float wgt = ex2(G2[16 * st + 4 * fq + i] - mt); acc[i] = (st < hw || 4 * fq + i <= fr) ? acc[i] * wgt : 0.f; }
            }
            u32x2 w; w.x = pk2(acc[0], acc[1]); w.y = pk2(acc[2], acc[3]);
            *(LAS u32x2*)(Sc + (16 * hw + fr) * 72 + 16 * st + 4 * fq) = w;
        }
        {
            f32x4 nu[5]; const float wi = WI[t];
#pragma unroll
            for (int c = 0; c < 5; ++c) { f32x4 a1 = (f32x4){0.f, 0.f, 0.f, 0.f}, a2 = (f32x4){0.f, 0.f, 0.f, 0.f};
#pragma unroll
                for (int ks = 0; ks < 2; ++ks) a1 = mfma16(ldfrag(Vt, 72, 16 * c, 32 * ks, lane), ldfrag(Sc, 72, 16 * hw, 32 * ks, lane), a1);
#pragma unroll
                for (int kk = 0; kk < 2; ++kk) a2 = mfma16(ldfrag(Cb, 72, 16 * c, 32 * kk, lane), ldfrag(Qs, 72, 16 * hw, 32 * kk, lane), a2);
                nu[c] = a1 + a2 * wi; }
            const float den = __shfl(nu[4][0], fr);
            const float inv = rcpf_(fmaxf(fabsf(den), EM[t]));
            bf16_t* op = opb + (size_t)(orow + (dir ? 63 - t : t)) * 1024;
            if (owrite) {
#pragma unroll
                for (int c = 0; c < 4; ++c) out_put4(op + 16 * c, nu[c] * inv, omode, opr[c]); }
        }
        { const float carry = MISC[0];
#pragma unroll
            for (int c = 0; c < 5; ++c) { f32x4 d = C[c] * carry;
#pragma unroll
                for (int ks = 0; ks < 2; ++ks) d = mfma16(ldfrag(KhT, 72, 16 * hw, 32 * ks, lane), ldfrag(Vt, 72, 16 * c, 32 * ks, lane), d);
                C[c] = d; } }
        if (j == 1 || j == 35) asm volatile("s_waitcnt vmcnt(0)" ::: "memory");
        LBAR();
    }
#undef ML_LOAD
}

DI void scan_lru(const ScanArgs& A, LAS unsigned char* lds, int unit) {
    const int tid = otid(), dir = tid >> 8, ht = tid & 255, hw = ht >> 6, lane = tid & 63, fr = lane & 15, fq = lane >> 4;
    const int b = 0, nbk = unit & 7;
    LAS unsigned char* L = lds + dir * 76288;
    LAS bf16_t* WG = (LAS bf16_t*)L;
    LAS bf16_t* XC = WG + 2 * 64 * 72;
    LAS bf16_t* XR = XC + 64 * 72;
    LAS float* AA = (LAS float*)(XR + 68 * 64);
    LAS float* UU = AA + 64 * 68;
    LAS float* CW = UU + 64 * 68;
    LAS float* CB = CW + 256; LAS float* BRr = CB + 64; LAS float* BIi = BRr + 64; LAS float* C8 = BIi + 64; LAS float* SEGA = C8 + 64; LAS float* SEGH = SEGA + 256; LAS float* HST = SEGH + 256;
    for (int i = ht; i < 2 * 64 * 64; i += 256) { const int g = i >> 12, d = (i >> 6) & 63, e = i & 63;
        WG[(g * 64 + e) * 72 + d] = (bf16_t)(pk2(A.gw[(((size_t)(dir * 2 + g) * 8 + nbk) * 64 + d) * 64 + e], 0.f) & 0xffffu); }
    for (int i = ht; i < 256; i += 256) CW[i] = A.convw[(i >> 6) * 512 + nbk * 64 + (i & 63)];
    if (ht < 128) HST[ht] = 0.f;
    if (ht < 64) { CB[ht] = A.convb[nbk * 64 + ht]; BRr[ht] = A.gb[(dir * 2 + 0) * 512 + nbk * 64 + ht]; BIi[ht] = A.gb[(dir * 2 + 1) * 512 + nbk * 64 + ht];
        const float lm = A.lam[dir * 512 + nbk * 64 + ht]; const float sp = (lm > 15.f) ? __expf(-lm) : log1pf(__expf(-lm)); C8[ht] = -8.f * sp * LOG2E; }
    const bf16_t* Px = A.P + 3072 + nbk * 64;
    u32x4 rx[3]; unsigned long long pr[4] = {0ull, 0ull, 0ull, 0ull}; int pmode = 0;
    bf16_t* const opb = A.SL + nbk * 64 + (ht & 3) * 16;
    int rowbase, pos0, slen; bool first, isx;
    chunk_geom(0, b, dir, rowbase, pos0, slen, first, isx);
#define LRU_LOAD() do { _Pragma("unroll") for (int q = 0; q < 3; ++q) { const int id = ht + 256 * q, i = id >> 3, c8 = id & 7; const int pos = pos0 - 2 + i; \
        rx[q] = (u32x4){0u, 0u, 0u, 0u}; if (id < 544 && pos >= 0 && pos < slen) rx[q] = *(const u32x4*)(Px + (size_t)(rowbase - 2 + i) * NP + c8 * 8); } \
        if (pmode == 1 && !late_pre(jnx)) { const int t = ht >> 2; const bf16_t* op = opb + (size_t)(rowbase + (dir ? 63 - t : t)) * 512; _Pragma("unroll") for (int q = 0; q < 4; ++q) pr[q] = ld8_coh(op + 4 * q); } } while (0)
    int jnx = 0;
    pmode = (A.last && !isx) ? 0 : pre_mode(first, 0);
    LRU_LOAD();
    LBAR();
    for (int j = 0; j < NSTEP; ++j) {
        const int orow = rowbase; const bool owrite = !(A.last && !isx); const int omode = pmode;
        if (late_pre(j) && pmode == 1) { const int t = ht >> 2; const bf16_t* op = opb + (size_t)(rowbase + (dir ? 63 - t : t)) * 512; _Pragma("unroll") for (int q = 0; q < 4; ++q) pr[q] = ld8_coh(op + 4 * q); }
        unsigned long long opr[4] = {pr[0], pr[1], pr[2], pr[3]};
        asm volatile("" : "+v"(opr[0]), "+v"(opr[1]), "+v"(opr[2]), "+v"(opr[3]));
#pragma unroll
        for (int q = 0; q < 3; ++q) { const int id = ht + 256 * q; if (id < 544) *(LAS u32x4*)(XR + (id >> 3) * 64 + (id & 7) * 8) = rx[q]; }
        LBAR();
        if (j + 1 < NSTEP) { chunk_geom(j + 1, b, dir, rowbase, pos0, slen, first, isx); pmode = (A.last && !isx) ? 0 : pre_mode(first, j + 1); jnx = j + 1; LRU_LOAD(); }
        { const int t = ht >> 2, d0 = (ht & 3) * 16, i0 = dir ? 63 - t : t; float xc[16];
#pragma unroll
            for (int e4 = 0; e4 < 4; ++e4) { const f32x4 c4 = *(const LAS f32x4*)(CB + d0 + 4 * e4); xc[4 * e4] = c4[0]; xc[4 * e4 + 1] = c4[1]; xc[4 * e4 + 2] = c4[2]; xc[4 * e4 + 3] = c4[3]; }
#pragma unroll
            for (int tap = 0; tap < 4; ++tap) { const u32x4 a0 = *(const LAS u32x4*)(XR + (i0 + tap) * 64 + d0), a1 = *(const LAS u32x4*)(XR + (i0 + tap) * 64 + d0 + 8);
                const unsigned ww[8] = {a0.x, a0.y, a0.z, a0.w, a1.x, a1.y, a1.z, a1.w};
#pragma unroll
                for (int e4 = 0; e4 < 4; ++e4) { const f32x4 w4 = *(const LAS f32x4*)(CW + tap * 64 + d0 + 4 * e4);
                    xc[4 * e4] += w4[0] * bflo(ww[2 * e4]); xc[4 * e4 + 1] += w4[1] * bfhi(ww[2 * e4]); xc[4 * e4 + 2] += w4[2] * bflo(ww[2 * e4 + 1]); xc[4 * e4 + 3] += w4[3] * bfhi(ww[2 * e4 + 1]); } }
            u32x4 w0, w1; w0.x = pk2(xc[0], xc[1]); w0.y = pk2(xc[2], xc[3]); w0.z = pk2(xc[4], xc[5]); w0.w = pk2(xc[6], xc[7]); w1.x = pk2(xc[8], xc[9]); w1.y = pk2(xc[10], xc[11]); w1.z = pk2(xc[12], xc[13]); w1.w = pk2(xc[14], xc[15]);
            *(LAS u32x4*)(XC + t * 72 + d0) = w0; *(LAS u32x4*)(XC + t * 72 + d0 + 8) = w1; }
        LBAR();
        { const int t = 16 * hw + fr;
#pragma unroll
            for (int et = 0; et < 4; ++et) { f32x4 ar = (f32x4){0.f, 0.f, 0.f, 0.f}, ai = (f32x4){0.f, 0.f, 0.f, 0.f};
#pragma unroll
                for (int kk = 0; kk < 2; ++kk) { const bf16x8 xb = ldfrag(XC, 72, 16 * hw, 32 * kk, lane);
                    ar = mfma16(ldfrag(WG, 72, 16 * et, 32 * kk, lane), xb, ar); ai = mfma16(ldfrag(WG + 64 * 72, 72, 16 * et, 32 * kk, lane), xb, ai); }
                const int e0 = 16 * et + 4 * fq; f32x4 av, uv;
                const u32x2 xw = *(const LAS u32x2*)(XC + t * 72 + e0); const float xv[4] = {bflo(xw.x), bfhi(xw.x), bflo(xw.y), bfhi(xw.y)};
                const f32x4 br4 = *(const LAS f32x4*)(BRr + e0), bi4 = *(const LAS f32x4*)(BIi + e0), c84 = *(const LAS f32x4*)(C8 + e0);
#pragma unroll
                for (int i = 0; i < 4; ++i) { const float r = ar[i] + br4[i], g = ai[i] + bi4[i];
                    const float pa = 1.f + ex2(-LOG2E * r), pb = 1.f + ex2(-LOG2E * g);
                    const float pm = fminf(pa * pb, 3.0e38f), rinv = rcpf_(pm);
                    const float sr = fminf(pb, 3.0e38f) * rinv, sg = fminf(pa, 3.0e38f) * rinv;
                    const float al = ex2(c84[i] * sr);
                    av[i] = al; uv[i] = __builtin_amdgcn_sqrtf(fmaxf(1.f - al * al, 0.f)) * sg * xv[i]; }
                *(LAS f32x4*)(AA + t * 68 + e0) = av; *(LAS f32x4*)(UU + t * 68 + e0) = uv; } }
        LBAR();
        {
            float hv[16], av[16]; float ap = 1.f, hl = 0.f;
#pragma unroll
            for (int i = 0; i < 16; ++i) { const float al = AA[(16 * hw + i) * 68 + lane], uu = UU[(16 * hw + i) * 68 + lane]; hl = al * hl + uu; ap *= al; hv[i] = hl; av[i] = ap; }
            SEGA[hw * 64 + lane] = ap; SEGH[hw * 64 + lane] = hl;
            LBAR();
            float carry = HST[(j & 1) * 64 + lane];
            for (int sg = 0; sg < hw; ++sg) carry = SEGA[sg * 64 + lane] * carry + SEGH[sg * 64 + lane];
#pragma unroll
            for (int i = 0; i < 16; ++i) UU[(16 * hw + i) * 68 + lane] = hv[i] + av[i] * carry;
            if (hw == 3) HST[((j + 1) & 1) * 64 + lane] = hv[15] + av[15] * carry;
        }
        LBAR();
        if (owrite) { const int t = ht >> 2, d0 = (ht & 3) * 16; bf16_t* op = opb + (size_t)(orow + (dir ? 63 - t : t)) * 512;
#pragma unroll
            for (int q = 0; q < 4; ++q) out_put4(op + 4 * q, *(const LAS f32x4*)(UU + t * 68 + d0 + 4 * q), omode, opr[q]); }
        if (j == 1 || j == 35) asm volatile("s_waitcnt vmcnt(0)" ::: "memory");
    }
    LBAR();
#undef LRU_LOAD
}
DI void phase_scan(const ScanArgs& A, LAS unsigned char* lds, int gr, int gs) {
    for (int u = gr; u < 32; u += gs) {
#ifndef NO_HG
        if (u < 16) scan_hgrn2(A, lds, u);
#ifdef DBL_HG
        if (u < 16) { __syncthreads(); scan_hgrn2(A, lds, u); }
#endif
#endif
#ifndef NO_ML
        if (u >= 16 && u < 24) scan_mlstm(A, lds, u - 16);
#ifdef DBL_ML
        if (u >= 16 && u < 24) { __syncthreads(); scan_mlstm(A, lds, u - 16); }
#endif
#endif
#ifndef NO_LRU
        if (u >= 24) scan_lru(A, lds, u - 24);
#ifdef DBL_LRU
        if (u >= 24) { __syncthreads(); scan_lru(A, lds, u - 24); }
#endif
#endif
        __syncthreads();
    }
}


#ifdef PROBE_CS
DI void cksum(const void* p, size_t bytes, unsigned long long* dst, int gr, int gs) {
    const unsigned* w = (const unsigned*)p; const size_t n = bytes / 4; unsigned long long acc = 0;
    const int tid = otid();
    for (unsigned i = (unsigned)gr * 512u + (unsigned)tid; i < (unsigned)n; i += (unsigned)gs * 512u) acc += (unsigned long long)w[i] * (unsigned long long)((i & 1023u) + 1u);
#pragma unroll
    for (int o = 1; o < 64; o <<= 1) acc += __shfl_xor(acc, o);
    if ((tid & 63) == 0) atomicAdd(dst, acc);
}
__global__ void cs_compare(const unsigned long long* CS, float* out, int n) {
    const size_t gt = (size_t)blockIdx.x * blockDim.x + threadIdx.x, gs = (size_t)gridDim.x * blockDim.x;
    int code = 0;
    for (int p = 63; p >= 0; --p) if (CS[p] != CS[64 + p]) code = p + 1;
    for (size_t i = gt; i < (size_t)n; i += gs) out[i] = (i == 0) ? 1000.f * (float)code : 0.f;
}
#define CK(idx, ptr, bytes) do { if (l == PROBE_CS - 1) cksum(ptr, bytes, CSA + a.run * 64 + (idx), gr, gs); } while (0)
#else
#define CK(idx, ptr, bytes) do { } while (0)
#endif
DI unsigned xcc_id() { return (unsigned)__builtin_amdgcn_s_getreg((3 << 11) | 20) & 0xFu; }
DI void xsync(unsigned* bar, unsigned gs, unsigned& epoch) {
    asm volatile("s_waitcnt vmcnt(0) lgkmcnt(0)" ::: "memory");
    __syncthreads();
    epoch = __builtin_amdgcn_readfirstlane(epoch + 1u);
    if (threadIdx.x == 0) {
        const unsigned old = __hip_atomic_fetch_add(bar, 1u, __ATOMIC_RELAXED, __HIP_MEMORY_SCOPE_AGENT);
        if (old + 1u == epoch * gs) __hip_atomic_store(bar + 64, epoch, __ATOMIC_RELAXED, __HIP_MEMORY_SCOPE_AGENT);
        else while (__hip_atomic_load(bar + 64, __ATOMIC_RELAXED, __HIP_MEMORY_SCOPE_AGENT) < epoch) __builtin_amdgcn_s_sleep(1);
    }
    if (threadIdx.x < 64) {
        __builtin_amdgcn_fence(__ATOMIC_ACQUIRE, "agent");
        asm volatile("s_waitcnt vmcnt(0)" ::: "memory");
    }
    __syncthreads();
}
__global__ void __launch_bounds__(512, 2) fwd_kernel(KArgs a) {
    extern __shared__ __attribute__((aligned(16))) unsigned char lds_raw[];
    LAS unsigned char* lds = (LAS unsigned char*)lds_raw;
    cg::grid_group grid = cg::this_grid();
#define GSYNC() do { asm volatile("s_waitcnt vmcnt(0) lgkmcnt(0)" ::: "memory"); grid.sync(); if (threadIdx.x < 64) { __builtin_amdgcn_fence(__ATOMIC_ACQUIRE, "agent"); asm volatile("s_waitcnt vmcnt(0)" ::: "memory"); } __syncthreads(); } while (0)
    unsigned char* ws = a.ws;
    float* MOD = (float*)(ws + WS_MOD); float* BIASA = (float*)(ws + WS_BIAS); float* LB = (float*)(ws + WS_LB); float* MLG = (float*)(ws + WS_MLG);
    unsigned* CTL = (unsigned*)(ws + WS_CTL);
    unsigned char* wsw = ws + WS_W; float* CTXW = (float*)(ws + WS_CTXW);
    bf16_t* AS = (bf16_t*)(ws + WS_AS); bf16_t* SL = (bf16_t*)(ws + WS_SL); bf16_t* BR = (bf16_t*)(ws + WS_BR); bf16_t* P = (bf16_t*)(ws + WS_P);

    volatile LAS unsigned* GI = (volatile LAS unsigned*)(lds + LDS_BYTES - 64);
    const unsigned myx = xcc_id();
    if (threadIdx.x == 0) GI[0] = __hip_atomic_fetch_add(CTL + 64 * myx + a.run * 8192, 1u, __ATOMIC_RELAXED, __HIP_MEMORY_SCOPE_AGENT);
    phase_mod(a, lds, MOD, LB);
    phase_conv(a, lds, 0, wsw, BIASA);
    GSYNC();
    if (threadIdx.x == 0) { unsigned ng = 0, g = 0, gs = 1;
        for (unsigned x = 0; x < 16; ++x) { const unsigned c = __hip_atomic_load(CTL + 64 * x + a.run * 8192, __ATOMIC_RELAXED, __HIP_MEMORY_SCOPE_AGENT); if (c) { if (x == myx) { g = ng; gs = c; } ++ng; } }
        GI[1] = g; GI[2] = gs; GI[3] = ng; }
    __syncthreads();
    const int gr = __builtin_amdgcn_readfirstlane((int)GI[0]), gg = __builtin_amdgcn_readfirstlane((int)GI[1]), gs = __builtin_amdgcn_readfirstlane((int)GI[2]), ng = __builtin_amdgcn_readfirstlane((int)GI[3]);
    unsigned* bar = CTL + 2048 + 128 * gg + a.run * 4096; unsigned epoch = 0;
    unsigned long long* CSA = (unsigned long long*)(ws + WS_LB + 32768); (void)CSA;
#define XSYNC() xsync(bar, (unsigned)gs, epoch)
    constexpr int RB = 4352;

    for (int l = 0; l < DEPTH; ++l) {
        const bool last = (l == DEPTH - 1); const int cm = l & 1;
        const float* xs = (l == 0) ? a.in[0] : a.out; const float* cs = (l == 0) ? a.in[2] : CTXW;
        const float* modl = MOD + (size_t)l * 9 * 6144; const float* BIAS = BIASA + l * NW1;
        const int Mall = RB, Mx = last ? 4096 : RB;
        unsigned char* wl = (l & 1) ? ws + WS_W2 : wsw;
        const bf16_t* W1 = (const bf16_t*)(wl + W_W1); const bf16_t* WGt = W1 + (size_t)N1 * 1024; const bf16_t* WBR = (const bf16_t*)(wl + W_BR);
        const bf16_t* WO = (const bf16_t*)(wl + W_O); const bf16_t* WFI = (const bf16_t*)(wl + W_FI); const bf16_t* WFO = (const bf16_t*)(wl + W_FO);
        for (int b = gg; b < NB; b += ng) phase_norm(xs, cs, a.in[6] + l * 1024, modl, 0, 1, cm, AS + (size_t)b * RB * 1024, Mall, b, gr, gs);
        if (l > 0) GSYNC(); else XSYNC();
        for (int b = gg; b < NB; b += ng) { CK(3, AS + (size_t)b * RB * 1024, (size_t)RB * 2048); }
        for (int b = gg; b < NB; b += ng) { Epi1 E{P + (size_t)b * RB * NP, BR + (size_t)b * RB * 1536, MLG + (size_t)b * RB * 16, BIAS, LB + l * 1024}; run_gemm(lds, AS + (size_t)b * RB * 1024, W1, Mall, N1, 1024, E, gr, gs); }
        XSYNC();
        for (int b = gg; b < NB; b += ng) { CK(4, P + (size_t)b * RB * NP, (size_t)RB * NP * 2); CK(5, BR + (size_t)b * RB * 1536, (size_t)RB * 1024); CK(6, MLG + (size_t)b * RB * 16, (size_t)RB * 64); }
        for (int b = gg; b < NB; b += ng) { ScanArgs S{P + (size_t)b * RB * NP, MLG + (size_t)b * RB * 16, AS + (size_t)b * RB * 1024, SL + (size_t)b * RB * 512, a.in[12] + l * 4 * 512, a.in[13] + l * 512, a.in[14] + (size_t)l * 2 * 2 * 8 * 64 * 64, a.in[15] + l * 2 * 2 * 512, a.in[16] + l * 2 * 512, last ? 1 : 0};
            phase_scan(S, lds, gr, gs);
#ifdef DBL_SCAN
            phase_scan(S, lds, gr, gs);
#endif
            }
        XSYNC();
        for (int b = gg; b < NB; b += ng) { CK(7, AS + (size_t)b * RB * 1024, (size_t)RB * 2048); CK(8, SL + (size_t)b * RB * 512, (size_t)RB * 1024); }
        for (int b = gg; b < NB; b += ng) phase_fin(xs, cs, a.in[6] + l * 1024, modl, cm, AS + (size_t)b * RB * 1024, SL + (size_t)b * RB * 512, BR + (size_t)b * RB * 1536, a.in[10] + l * 512, a.in[11] + l * 512, Mx, b, gr, gs);
        XSYNC();
        for (int b = gg; b < NB; b += ng) { CK(9, AS + (size_t)b * RB * 1024, (size_t)RB * 2048); CK(10, BR + (size_t)b * RB * 1536, (size_t)RB * 1024); }
        for (int b = gg; b < NB; b += ng) { Epi2 E{P + (size_t)b * RB * NP, BIAS + N1}; run_gemm(lds, AS + (size_t)b * RB * 1024, WGt, Mx, NG, 1024, E, gr, gs); }
        XSYNC();
        for (int b = gg; b < NB; b += ng) { CK(11, P + (size_t)b * RB * NP, (size_t)RB * NG * 2); }
        for (int b = gg; b < NB; b += ng) { Epi3 E{P + (size_t)b * RB * NP, AS + (size_t)b * RB * 1024}; run_gemm(lds, BR + (size_t)b * RB * 1536, WBR, Mx, 1024, 1536, E, gr, gs); }
        XSYNC();
        for (int b = gg; b < NB; b += ng) { CK(12, AS + (size_t)b * RB * 1024, (size_t)RB * 2048); }
        for (int b = gg; b < NB; b += ng) { EpiRes E{xs, a.out, cs, CTXW, modl + 2 * 1024, cm, ((PROBE_MIX >> l) & 1) ? 0.f : 1.f, b}; run_gemm(lds, AS + (size_t)b * RB * 1024, WO, Mx, 1024, 1024, E, gr, gs); }
        XSYNC();
        for (int b = gg; b < NB; b += ng) { CK(13, a.out + (size_t)b * 4096 * 1024, (size_t)4096 * 4096); CK(14, CTXW + (size_t)b * 256 * 1024, (size_t)256 * 4096); }
        for (int b = gg; b < NB; b += ng) phase_norm(a.out, CTXW, a.in[19] + l * 1024, modl, 3, 4, 0, AS + (size_t)b * RB * 1024, Mx, b, gr, gs);
#ifdef DBL_P5
        for (int b = gg; b < NB; b += ng) phase_norm(a.out, CTXW, a.in[19] + l * 1024, modl, 3, 4, 0, AS + (size_t)b * RB * 1024, Mx, b, gr, gs);
#endif
        XSYNC();
        for (int b = gg; b < NB; b += ng) { CK(15, AS + (size_t)b * RB * 1024, (size_t)RB * 2048); }
        for (int b = gg; b < NB; b += ng) { Epi5 E{P + (size_t)b * RB * NP}; run_gemm(lds, AS + (size_t)b * RB * 1024, WFI, Mx, 2 * FF, 1024, E, gr, gs); }
#ifdef DBL_G5
        for (int b = gg; b < NB; b += ng) { Epi5 E{P + (size_t)b * RB * NP}; run_gemm(lds, AS + (size_t)b * RB * 1024, WFI, Mx, 2 * FF, 1024, E, gr, gs); }
#endif
        XSYNC();
        for (int b = gg; b < NB; b += ng) { CK(16, P + (size_t)b * RB * NP, (size_t)RB * FF * 2); }
        for (int b = gg; b < NB; b += ng) { EpiRes E{a.out, a.out, CTXW, CTXW, modl + 5 * 1024, 0, ((PROBE_FFN >> l) & 1) ? 0.f : 1.f, b}; run_gemm(lds, P + (size_t)b * RB * NP, WFO, Mx, 1024, FF, E, gr, gs); }
        if (!last) phase_conv_q(a, lds, l + 1, ((l + 1) & 1) ? ws + WS_W2 : wsw, BIASA, CTL + 12288 + 64 * l);
        XSYNC();
        for (int b = gg; b < NB; b += ng) { CK(17, a.out + (size_t)b * 4096 * 1024, (size_t)4096 * 4096); }
    }
    for (int b = gg; b < NB; b += ng) phase_final(a.out + (size_t)b * 4096 * 1024, a.in[22], gr, gs);
}

extern "C" void kernel_launch(void* const* d_in, const int* in_sizes, int n_in, void* d_out, int out_size, void* d_ws, size_t ws_size, hipStream_t stream) {
    static int grid = 0;
    if (grid == 0) {
        if (n_in != 23 || out_size != MX * D || ws_size < WS_END) { fprintf(stderr, "kernel_launch: unexpected problem (n_in %d out %d ws %zu need %zu)\n", n_in, out_size, ws_size, (size_t)WS_END); grid = -1; return; }
        int dev = 0, cus = 0, per_cu = 0;
        if (hipGetDevice(&dev) != hipSuccess || hipDeviceGetAttribute(&cus, hipDeviceAttributeMultiprocessorCount, dev) != hipSuccess) { grid = -1; return; }
        if (hipFuncSetAttribute((const void*)fwd_kernel, hipFuncAttributeMaxDynamicSharedMemorySize, LDS_BYTES) != hipSuccess) { fprintf(stderr, "kernel_launch: hipFuncSetAttribute failed\n"); grid = -1; return; }
        if (hipOccupancyMaxActiveBlocksPerMultiprocessor(&per_cu, (const void*)fwd_kernel, 512, LDS_BYTES) != hipSuccess || per_cu < 1) { fprintf(stderr, "kernel_launch: occupancy query says %d\n", per_cu); per_cu = 1; }
        (void)hipGetLastError();
        grid = cus * per_cu;
        if (grid > 256) grid = 256;
    }
    if (grid < 0) return;
    (void)hipMemsetAsync((char*)d_ws + WS_CTL, 0, 65536, stream);
    KArgs a{};
    for (int i = 0; i < 23; ++i) a.in[i] = (const float*)d_in[i];
    a.out = (float*)d_out; a.ws = (unsigned char*)d_ws;
    void* args[] = {&a};
#ifdef PROBE_CS
    (void)hipMemsetAsync((char*)d_ws + WS_LB + 32768, 0, 1024, stream);
    (void)hipLaunchCooperativeKernel((void*)fwd_kernel, dim3(grid), dim3(512), args, LDS_BYTES, stream);
    a.run = 1;
#endif
    hipError_t e = hipLaunchCooperativeKernel((void*)fwd_kernel, dim3(grid), dim3(512), args, LDS_BYTES, stream);
#ifdef PROBE_CS
    hipLaunchKernelGGL(cs_compare, dim3(1024), dim3(256), 0, stream, (const unsigned long long*)((char*)d_ws + WS_LB + 32768), (float*)d_out, out_size);
#endif
    if (e != hipSuccess) fprintf(stderr, "kernel_launch: cooperative launch failed: %s (grid %d)\n", hipGetErrorString(e), grid);
}
```

```cpp
#include <hip/hip_runtime.h>
#include <hip/hip_cooperative_groups.h>
#include <cstdio>
#include <cstdint>
namespace cg = cooperative_groups;
#ifndef PROBE_MIX
#define PROBE_MIX 0
#endif
#ifndef PROBE_FFN
#define PROBE_FFN 0
#endif
#ifndef PROBE_BR
#define PROBE_BR 0
#endif
#define PG8_ALIGN_V true
#define PG8_SP2_V true
namespace pg8 {
#define PG8_LAS __attribute__((address_space(3)))
typedef unsigned short bf16_t;
typedef short bf16x8 __attribute__((ext_vector_type(8)));
typedef float f32x4 __attribute__((ext_vector_type(4)));
typedef unsigned u32x4 __attribute__((ext_vector_type(4)));
constexpr int BM = 256, BK = 64, HALF = 128, HTB = HALF * BK * 2  , STAGE_BYTES = 8 * HTB, NXCD = 8, WGM = 8;

__host__ __device__ __forceinline__ int lds_byte(int r, int c) { const int st = (r >> 4) * 2 + (c >> 5), rr = r & 15, cc = c & 31, ob = rr * 64 + cc * 2; return st * 1024 + (ob ^ (((ob >> 9) & 1) << 5)); }
__host__ __device__ __forceinline__ void stage_rc(int b, int& R, int& C) { const int st = b / 1024, sb = b % 1024, swz = sb ^ (((sb >> 9) & 1) << 5); R = (st >> 1) * 16 + swz / 64; C = (st & 1) * 32 + (swz % 64) / 2; }
__host__ __device__ __forceinline__ int perm32(int rho) { const int n = rho >> 4, i = rho & 15; return 8 * (i >> 2) + 4 * n + (i & 3); }

struct Unit { int pm, pn; };
struct Gemm { const bf16_t* A; const bf16_t* Bt; int M, N, K; };

struct StaticOrder {
    int nM, nN, nwg, G, c;
    __host__ __device__ void init(int M, int N, int G_, int c_) { nM = M / BM; nN = N / BM; nwg = nM * nN; G = G_; c = c_; }
    __host__ __device__ bool next(int i, Unit& u) const {
        const long L = (long)i * G + c; if (L >= nwg) return false;
        int wgid = (int)L; { const int q = nwg / NXCD, r = nwg % NXCD, xcd = wgid % NXCD, off = wgid / NXCD; wgid = (xcd < r ? xcd * (q + 1) : r * (q + 1) + (xcd - r) * q) + off; }
        const int nig = WGM * nN, gid = wgid / nig, fm = gid * WGM, gsz = (nM - fm) < WGM ? (nM - fm) : WGM;
        u.pm = fm + ((wgid % nig) % gsz); u.pn = (wgid % nig) / gsz; return true;
    }
    __device__ __forceinline__ void a_ready(const Unit&) const {}
    __device__ __forceinline__ void done(const Unit&) const {}
};
__device__ __forceinline__ unsigned cvt_pk_bf16(float lo, float hi) { unsigned r; asm volatile("v_cvt_pk_bf16_f32 %0, %1, %2" : "=v"(r) : "v"(lo), "v"(hi)); return r; }
typedef float f32x2 __attribute__((ext_vector_type(2)));
template <class Epi, class Sched, bool ALIGN_EPI = false, bool SP2 = false>
__device__ __forceinline__ void gemm_phase(PG8_LAS unsigned char* lds, const Gemm g, const Sched& S, const Epi& E) {
    int tid_ = threadIdx.x; asm volatile("" : "+v"(tid_)); const int tid = tid_, wid = __builtin_amdgcn_readfirstlane(tid >> 6), lane = tid & 63, wr = wid >> 2, wc = wid & 3, fr = lane & 15, fq = lane >> 4;
    const int K = g.K, nt = K / BK;
    unsigned voffA[2], voffB[2];
#pragma unroll
    for (int i = 0; i < 2; ++i) { int R, C; stage_rc(tid * 16 + i * 8192, R, C); const int Rb = Epi::PERM ? ((R & ~31) + perm32(R & 31)) : R;
        voffA[i] = (unsigned)(R * K + C) * 2u; voffB[i] = (unsigned)(Rb * K + C) * 2u; }
    const size_t kstep = (size_t)(BK * 2);
    const size_t hstep = (size_t)HALF * K * 2;
    const size_t tstep = 2 * hstep;
    const unsigned ldsw = (unsigned)wid * 1024u;
    const int aoff = lds_byte(wr * 64 + fr, fq * 8), boff = lds_byte(wc * 32 + fr, fq * 8);
#define PG8_SA(b, h) (((b) * 2 + (h)) * HTB)
#define PG8_SB(b, h) ((4 + (b) * 2 + (h)) * HTB)
#define PG8_STAGE(bufoff, gbase, voff) do { _Pragma("unroll") for (int _i = 0; _i < 2; ++_i) \
        __builtin_amdgcn_global_load_lds((const unsigned*)((const char*)(gbase) + (voff)[_i]), (PG8_LAS unsigned*)(lds + (bufoff) + ldsw + _i * 8192), 16, 0, 0); } while (0)
#define PG8_LDA(dst, b, h) do { _Pragma("unroll") for (int m = 0; m < 4; ++m) _Pragma("unroll") for (int k = 0; k < 2; ++k) dst[m][k] = *(const PG8_LAS bf16x8*)(lds + PG8_SA(b, h) + aoff + m * 2048 + k * 1024); } while (0)
#define PG8_LDB(dst, b, h) do { _Pragma("unroll") for (int n = 0; n < 2; ++n) _Pragma("unroll") for (int k = 0; k < 2; ++k) dst[n][k] = *(const PG8_LAS bf16x8*)(lds + PG8_SB(b, h) + boff + n * 2048 + k * 1024); } while (0)
#define PG8_MMA(ai, bj, At, Bt) do { __builtin_amdgcn_s_setprio(1); _Pragma("unroll") for (int m = 0; m < 4; ++m) _Pragma("unroll") for (int n = 0; n < 2; ++n) _Pragma("unroll") for (int k = 0; k < 2; ++k) \
        acc[ai][bj][m][n] = __builtin_amdgcn_mfma_f32_16x16x32_bf16(Bt[n][k], At[m][k], acc[ai][bj][m][n], 0, 0, 0); __builtin_amdgcn_s_setprio(0); } while (0)
#define PG8_WAIT_V(n) asm volatile("s_waitcnt vmcnt(" #n ")" ::: "memory")
#define PG8_WAIT_L(n) asm volatile("s_waitcnt lgkmcnt(" #n ")" ::: "memory")
#define PG8_BAR __builtin_amdgcn_s_barrier()
#define PG8_SCHED __builtin_amdgcn_sched_barrier(0)
    Unit cur, nxt; int ui = 0;
    if (!S.next(0, cur)) return;
    f32x4 acc[2][2][4][2];
#pragma unroll
    for (int a = 0; a < 2; ++a)
#pragma unroll
        for (int b = 0; b < 2; ++b)
#pragma unroll
            for (int m = 0; m < 4; ++m)
#pragma unroll
                for (int n = 0; n < 2; ++n) acc[a][b][m][n] = (f32x4){0.f, 0.f, 0.f, 0.f};
    bf16x8 At[4][2], B0[2][2], B1[2][2];
    const char* cA = (const char*)g.A + (size_t)cur.pm * tstep; const char* cB = (const char*)g.Bt + (size_t)cur.pn * tstep;
    S.a_ready(cur);
    if constexpr (SP2) {
        PG8_STAGE(PG8_SB(0, 0), cB, voffB); PG8_STAGE(PG8_SB(0, 1), cB + hstep, voffB); PG8_STAGE(PG8_SA(0, 0), cA, voffA); PG8_STAGE(PG8_SA(0, 1), cA + hstep, voffA);
        if (wr == 1) PG8_BAR;
        PG8_WAIT_V(2); PG8_BAR;
        PG8_STAGE(PG8_SB(1, 0), cB + kstep, voffB); PG8_STAGE(PG8_SA(1, 0), cA + kstep, voffA); PG8_STAGE(PG8_SB(1, 1), cB + hstep + kstep, voffB);
        PG8_WAIT_V(6); PG8_BAR;
    } else {
        PG8_STAGE(PG8_SB(0, 0), cB, voffB); PG8_STAGE(PG8_SA(0, 0), cA, voffA); PG8_STAGE(PG8_SB(0, 1), cB + hstep, voffB); PG8_STAGE(PG8_SA(0, 1), cA + hstep, voffA);
        if (wr == 1) PG8_BAR;
        PG8_WAIT_V(4); PG8_BAR;
        PG8_STAGE(PG8_SB(1, 0), cB + kstep, voffB); PG8_STAGE(PG8_SA(1, 0), cA + kstep, voffA); PG8_STAGE(PG8_SB(1, 1), cB + hstep + kstep, voffB);
        PG8_WAIT_V(6); PG8_BAR;
    }
    for (;;) {
        const bool has_next = S.next(ui + 1, nxt);
        const char* nA = has_next ? (const char*)g.A + (size_t)nxt.pm * tstep : cA; const char* nB = has_next ? (const char*)g.Bt + (size_t)nxt.pn * tstep : cB;
        for (int t = 0; t < nt; t += 2) {
            const bool last = (t == nt - 2);
            if constexpr (Epi::HAS_MID) { if (t == 8 || t == 16) E.mid(acc, cur, t >> 3, wr, wc, fr, fq); }
            const char* a1 = cA + (size_t)(t + 1) * kstep;
            const char* a2 = last ? nA : cA + (size_t)(t + 2) * kstep; const char* b2 = last ? nB : cB + (size_t)(t + 2) * kstep;
            const char* a3 = a2 + kstep; const char* b3 = b2 + kstep;
            if (last && has_next) S.a_ready(nxt);
            if constexpr (SP2) {
            PG8_LDB(B0, 0, 0); PG8_LDB(B1, 0, 1); PG8_SCHED; PG8_LDA(At, 0, 0); PG8_STAGE(PG8_SA(1, 1), a1 + hstep, voffA);
            PG8_WAIT_V(8); PG8_WAIT_L(0); PG8_BAR; PG8_MMA(0, 0, At, B0); PG8_MMA(0, 1, At, B1); PG8_BAR; PG8_SCHED;
            PG8_LDA(At, 0, 1); PG8_STAGE(PG8_SB(0, 0), b2, voffB); PG8_STAGE(PG8_SB(0, 1), b2 + hstep, voffB); PG8_STAGE(PG8_SA(0, 0), a2, voffA);
            PG8_WAIT_V(8); PG8_WAIT_L(0); PG8_BAR; PG8_MMA(1, 0, At, B0); PG8_MMA(1, 1, At, B1); PG8_BAR; PG8_SCHED;
            PG8_LDB(B0, 1, 0); PG8_LDB(B1, 1, 1); PG8_SCHED; PG8_LDA(At, 1, 0); PG8_STAGE(PG8_SA(0, 1), a2 + hstep, voffA);
            PG8_WAIT_V(8); PG8_WAIT_L(0); PG8_BAR; PG8_MMA(0, 0, At, B0); PG8_MMA(0, 1, At, B1); PG8_BAR; PG8_SCHED;
            PG8_LDA(At, 1, 1); PG8_STAGE(PG8_SB(1, 0), b3, voffB); PG8_STAGE(PG8_SB(1, 1), b3 + hstep, voffB); PG8_STAGE(PG8_SA(1, 0), a3, voffA);
            PG8_WAIT_V(8); PG8_WAIT_L(0); PG8_BAR; PG8_MMA(1, 0, At, B0); PG8_MMA(1, 1, At, B1); PG8_BAR; PG8_SCHED;
            } else {
            PG8_LDB(B0, 0, 0); PG8_SCHED; PG8_LDA(At, 0, 0); PG8_STAGE(PG8_SA(1, 1), a1 + hstep, voffA);
            PG8_WAIT_L(8); PG8_BAR; PG8_WAIT_L(0); PG8_MMA(0, 0, At, B0); PG8_BAR; PG8_SCHED;
            PG8_LDB(B1, 0, 1); PG8_STAGE(PG8_SB(0, 0), b2, voffB);
            PG8_BAR; PG8_WAIT_L(0); PG8_MMA(0, 1, At, B1); PG8_BAR;
            PG8_LDA(At, 0, 1); PG8_STAGE(PG8_SA(0, 0), a2, voffA);
            PG8_BAR; PG8_WAIT_L(0); PG8_MMA(1, 0, At, B0); PG8_BAR; PG8_SCHED;
            PG8_STAGE(PG8_SB(0, 1), b2 + hstep, voffB);
            PG8_WAIT_V(6); PG8_BAR; PG8_MMA(1, 1, At, B1); PG8_BAR;
            PG8_LDB(B0, 1, 0); PG8_SCHED; PG8_LDA(At, 1, 0); PG8_STAGE(PG8_SA(0, 1), a2 + hstep, voffA);
            PG8_WAIT_L(8); PG8_BAR; PG8_WAIT_L(0); PG8_MMA(0, 0, At, B0); PG8_BAR; PG8_SCHED;
            PG8_LDB(B1, 1, 1); PG8_STAGE(PG8_SB(1, 0), b3, voffB);
            PG8_BAR; PG8_WAIT_L(0); PG8_MMA(0, 1, At, B1); PG8_BAR;
            PG8_LDA(At, 1, 1); PG8_STAGE(PG8_SA(1, 0), a3, voffA);
            PG8_BAR; PG8_WAIT_L(0); PG8_MMA(1, 0, At, B0); PG8_BAR; PG8_SCHED;
            PG8_STAGE(PG8_SB(1, 1), b3 + hstep, voffB);
            PG8_WAIT_V(6); PG8_BAR; PG8_MMA(1, 1, At, B1); PG8_BAR;
            }
        }
        if constexpr (ALIGN_EPI) { if (wr == 0) PG8_BAR; }
        if constexpr (!Epi::AFTER_DRAIN) { E(acc, cur, wr, wc, fr, fq); S.done(cur); }
        if (!has_next) break;
#pragma unroll
        for (int a = 0; a < 2; ++a)
#pragma unroll
            for (int b = 0; b < 2; ++b)
#pragma unroll
                for (int m = 0; m < 4; ++m)
#pragma unroll
                    for (int n = 0; n < 2; ++n) acc[a][b][m][n] = (f32x4){0.f, 0.f, 0.f, 0.f};
        cur = nxt; cA = nA; cB = nB; ++ui;
        if constexpr (ALIGN_EPI) { if (wr == 1) PG8_BAR; }
    }
    PG8_WAIT_V(0);
    if constexpr (!ALIGN_EPI) { if (wr == 0) PG8_BAR; }
    PG8_BAR;
    if constexpr (Epi::AFTER_DRAIN) { E.fused(acc, cur, wr, wc, fr, fq, lds, wid, lane); S.done(cur); }
#undef PG8_SA
#undef PG8_SB
#undef PG8_STAGE
#undef PG8_LDA
#undef PG8_LDB
#undef PG8_MMA
#undef PG8_WAIT_V
#undef PG8_WAIT_L
#undef PG8_BAR
#undef PG8_SCHED
}
}

#define LAS __attribute__((address_space(3)))
#define DI __device__ __forceinline__
typedef unsigned short bf16_t;
typedef short bf16x8 __attribute__((ext_vector_type(8)));
typedef float f32x4 __attribute__((ext_vector_type(4)));
typedef unsigned u32x4 __attribute__((ext_vector_type(4)));
typedef unsigned u32x2 __attribute__((ext_vector_type(2)));

constexpr int D = 1024, NB = 8, SEQ = 4096, DEPTH = 4, CTXL = 256;
constexpr int MX = NB * SEQ, MC = NB * CTXL, MT = MX + MC;
constexpr int NIN = 8208, NP = 3584, N1 = 5376, NG = 3072, FF = 2816, NW1 = N1 + NG;
constexpr float EPS = 1e-6f;
constexpr float LOG2E = 1.4426950408889634f;
constexpr size_t MiB = 1u << 20;
constexpr size_t WS_MOD = 0;
constexpr size_t WS_BIAS = 1 * MiB;
constexpr size_t WS_CTL = 5 * MiB;
constexpr size_t WS_LB = 1 * MiB + 262144;
constexpr size_t WS_MLG = 2 * MiB;
constexpr size_t WS_W = 6 * MiB;
constexpr size_t W_W1 = 0, W_BR = (size_t)NW1 * 1024 * 2, W_O = W_BR + 3ull * 1024 * 512 * 2, W_FI = W_O + 1024ull * 1024 * 2, W_FO = W_FI + 5632ull * 1024 * 2, W_END = W_FO + 1024ull * 2816 * 2;
constexpr size_t WS_CTXW = 46 * MiB;
constexpr size_t WS_AS = 54 * MiB;
constexpr size_t WS_SL = 122 * MiB;
constexpr size_t WS_BR = 156 * MiB;
constexpr size_t WS_P = 258 * MiB;
constexpr size_t WS_W2 = 258 * MiB + (size_t)MT * NP * 2;
constexpr size_t WS_END = WS_W2 + 39845888;
static_assert(W_END <= 39845888, "weights");
constexpr int LDS_BYTES = 155648;

DI float ex2(float x) { return __builtin_amdgcn_exp2f(x); }
DI float lg2(float x) { return __builtin_amdgcn_logf(x); }
DI float rcpf_(float x) { return __builtin_amdgcn_rcpf(x); }
DI float sigm(float x) { return rcpf_(1.f + ex2(-LOG2E * x)); }
DI float silu_(float x) { return x * sigm(x); }
DI float gelu_t(float x) { const float u = 1.5957691216f * (x + 0.044715f * x * x * x); return x * sigm(u); }
typedef __bf16 bf2_t __attribute__((ext_vector_type(2)));
DI unsigned pk2(float lo, float hi) { bf2_t v = { (__bf16)lo, (__bf16)hi }; return __builtin_bit_cast(unsigned, v); }
DI float bflo(unsigned w) { return __uint_as_float(w << 16); }
DI float bfhi(unsigned w) { return __uint_as_float(w & 0xffff0000u); }
DI float bf1(bf16_t h) { return __uint_as_float(((unsigned)h) << 16); }
DI float wave_sum(float v) {
#pragma unroll
    for (int o = 1; o < 64; o <<= 1) v += __shfl_xor(v, o);
    return v;
}
DI f32x4 mfma16(bf16x8 a, bf16x8 b, f32x4 c) { return __builtin_amdgcn_mfma_f32_16x16x32_bf16(a, b, c, 0, 0, 0); }
DI bf16x8 ldfrag(const LAS bf16_t* base, int ld, int r0, int k0, int lane) { return *(const LAS bf16x8*)(base + (r0 + (lane & 15)) * ld + k0 + (lane >> 4) * 8); }

DI int otid() { int t = threadIdx.x; asm volatile("" : "+v"(t)); return t; }
DI u32x4 ld16_coh(const void* p) { const unsigned long long a = __hip_atomic_load((const unsigned long long*)p, __ATOMIC_RELAXED, __HIP_MEMORY_SCOPE_AGENT), b = __hip_atomic_load((const unsigned long long*)p + 1, __ATOMIC_RELAXED, __HIP_MEMORY_SCOPE_AGENT);
    u32x4 r; r.x = (unsigned)a; r.y = (unsigned)(a >> 32); r.z = (unsigned)b; r.w = (unsigned)(b >> 32); return r; }
struct KArgs { const float* in[23]; float* out; unsigned char* ws; int run, pad1; };

enum { ACT_ID = 0, ACT_SILU = 1, ACT_LOG2F = 2, ACT_SCALE8 = 3, ACT_SIGM = 4, ACT_GELU = 5 };
struct Epi1 {
    static constexpr bool PERM = true, AFTER_DRAIN = false, HAS_MID = false;
    bf16_t* P; bf16_t* BR; float* MLG; const float* bias; const float* lb;
    DI void operator()(const f32x4 (&acc)[2][2][4][2], const pg8::Unit& u, int wr, int wc, int fr, int fq) const {
        const int pn = u.pn, row0 = u.pm * 256 + wr * 64 + fr;
        if (pn == 20) {
            if (wc == 0 && fq < 2) {
                const f32x4 b0 = *(const f32x4*)(bias + 5120 + 8 * fq), b1 = *(const f32x4*)(bias + 5120 + 8 * fq + 4);
#pragma unroll
                for (int ai = 0; ai < 2; ++ai)
#pragma unroll
                    for (int m = 0; m < 4; ++m) { float* dst = MLG + (size_t)(row0 + ai * 128 + m * 16) * 16 + 8 * fq;
                        *(f32x4*)dst = acc[ai][0][m][0] + b0; *(f32x4*)(dst + 4) = acc[ai][0][m][1] + b1; }
            }
            return;
        }
        int act, ldc, colt; bf16_t* base;
        if (pn < 14) { base = P; ldc = NP; colt = pn * 256; act = pn < 2 ? ACT_SILU : (pn < 4 ? ACT_ID : (pn < 8 ? ACT_LOG2F : (pn == 8 ? ACT_SCALE8 : ACT_ID))); }
        else { const int n = (pn - 14) >> 1; base = BR; ldc = 1536; colt = (pn - 14) * 256; act = n == 0 ? ACT_SILU : (n == 1 ? ACT_SIGM : ACT_GELU); }
        const int cin = wc * 32 + 8 * fq, bcol0 = pn * 256 + cin;
        bf16_t* tbase = base + (size_t)row0 * ldc + colt + cin;
        switch (act) {
            case ACT_SILU:   tile<ACT_SILU>(acc, tbase, ldc, bcol0); break;
            case ACT_LOG2F:  tile<ACT_LOG2F>(acc, tbase, ldc, bcol0); break;
            case ACT_SCALE8: tile<ACT_SCALE8>(acc, tbase, ldc, bcol0); break;
            case ACT_SIGM:   tile<ACT_SIGM>(acc, tbase, ldc, bcol0); break;
            case ACT_GELU:   tile<ACT_GELU>(acc, tbase, ldc, bcol0); break;
            default:         tile<ACT_ID>(acc, tbase, ldc, bcol0); break;
        }
    }
    template <int ACT> DI void tile(const f32x4 (&acc)[2][2][4][2], bf16_t* tbase, int ldc, int bcol0) const {
        f32x4 bv[2][2], lbv[2][2];
#pragma unroll
        for (int bj = 0; bj < 2; ++bj)
#pragma unroll
            for (int n = 0; n < 2; ++n) { bv[bj][n] = *(const f32x4*)(bias + bcol0 + bj * 128 + 4 * n);
                lbv[bj][n] = (ACT == ACT_LOG2F) ? *(const f32x4*)(lb + (bcol0 - 1024) + bj * 128 + 4 * n) : (f32x4){0.f, 0.f, 0.f, 0.f}; }
#pragma unroll
        for (int ai = 0; ai < 2; ++ai)
#pragma unroll
            for (int m = 0; m < 4; ++m) { bf16_t* rowp = tbase + (size_t)(ai * 128 + m * 16) * ldc;
#pragma unroll
                for (int bj = 0; bj < 2; ++bj) { f32x4 v[2];
#pragma unroll
                    for (int n = 0; n < 2; ++n) { v[n] = acc[ai][bj][m][n] + bv[bj][n];
#pragma unroll
                        for (int j = 0; j < 4; ++j) { float x = v[n][j];
                            if (ACT == ACT_SILU) x = silu_(x);
                            else if (ACT == ACT_LOG2F) { const float l = lbv[bj][n][j]; x = lg2(l + (1.f - l) * sigm(x)); }
                            else if (ACT == ACT_SCALE8) x *= 0.125f;
                            else if (ACT == ACT_SIGM) x = sigm(x);
                            else if (ACT == ACT_GELU) x = gelu_t(x);
                            v[n][j] = x; } }
                    u32x4 w; w.x = pk2(v[0][0], v[0][1]); w.y = pk2(v[0][2], v[0][3]); w.z = pk2(v[1][0], v[1][1]); w.w = pk2(v[1][2], v[1][3]);
                    *(u32x4*)(rowp + bj * 128) = w; } }
    }
};
struct Epi2 {
    static constexpr bool PERM = true, AFTER_DRAIN = false, HAS_MID = false;
    bf16_t* G; const float* bias;
    DI void operator()(const f32x4 (&acc)[2][2][4][2], const pg8::Unit& u, int wr, int wc, int fr, int fq) const {
        const int row0 = u.pm * 256 + wr * 64 + fr, col0 = u.pn * 256 + wc * 32 + 8 * fq;
        f32x4 bv[2][2];
#pragma unroll
        for (int bj = 0; bj < 2; ++bj)
#pragma unroll
            for (int n = 0; n < 2; ++n) bv[bj][n] = *(const f32x4*)(bias + col0 + bj * 128 + 4 * n);
#pragma unroll
        for (int ai = 0; ai < 2; ++ai)
#pragma unroll
            for (int m = 0; m < 4; ++m) { bf16_t* rowp = G + (size_t)(row0 + ai * 128 + m * 16) * NG + col0;
#pragma unroll
                for (int bj = 0; bj < 2; ++bj) { f32x4 v0 = acc[ai][bj][m][0] + bv[bj][0], v1 = acc[ai][bj][m][1] + bv[bj][1];
#pragma unroll
                    for (int j = 0; j < 4; ++j) { v0[j] = sigm(v0[j]); v1[j] = sigm(v1[j]); }
                    u32x4 w; w.x = pk2(v0[0], v0[1]); w.y = pk2(v0[2], v0[3]); w.z = pk2(v1[0], v1[1]); w.w = pk2(v1[2], v1[3]);
                    *(u32x4*)(rowp + bj * 128) = w; } }
    }
};
struct Epi3 {
    static constexpr bool PERM = true, AFTER_DRAIN = false, HAS_MID = true;
    const bf16_t* G; bf16_t* MG;
    DI void mid(f32x4 (&acc)[2][2][4][2], const pg8::Unit& u, int nb, int wr, int wc, int fr, int fq) const {
        int row0 = u.pm * 256 + wr * 64 + fr, col0 = u.pn * 256 + wc * 32 + 8 * fq;
        asm volatile("" : "+v"(row0), "+v"(col0));
#pragma unroll
        for (int ai = 0; ai < 2; ++ai)
#pragma unroll
            for (int mp = 0; mp < 1; ++mp) { u32x4 ga[4][2], gb[4][2];
#pragma unroll
                for (int mm = 0; mm < 4; ++mm) { const size_t r = (size_t)(row0 + ai * 128 + (4 * mp + mm) * 16);
#pragma unroll
                    for (int bj = 0; bj < 2; ++bj) { ga[mm][bj] = *(const u32x4*)(G + r * NG + (nb - 1) * 1024 + col0 + bj * 128); gb[mm][bj] = *(const u32x4*)(G + r * NG + nb * 1024 + col0 + bj * 128); } }
#pragma unroll
                for (int mm = 0; mm < 4; ++mm) { const int m = 4 * mp + mm;
#pragma unroll
                    for (int bj = 0; bj < 2; ++bj) { const u32x4 a = ga[mm][bj], bq = gb[mm][bj];
                        f32x4 a0 = acc[ai][bj][m][0], a1 = acc[ai][bj][m][1];
                        a0[0] *= bflo(a.x) * rcpf_(bflo(bq.x)); a0[1] *= bfhi(a.x) * rcpf_(bfhi(bq.x)); a0[2] *= bflo(a.y) * rcpf_(bflo(bq.y)); a0[3] *= bfhi(a.y) * rcpf_(bfhi(bq.y));
                        a1[0] *= bflo(a.z) * rcpf_(bflo(bq.z)); a1[1] *= bfhi(a.z) * rcpf_(bfhi(bq.z)); a1[2] *= bflo(a.w) * rcpf_(bflo(bq.w)); a1[3] *= bfhi(a.w) * rcpf_(bfhi(bq.w));
                        acc[ai][bj][m][0] = a0; acc[ai][bj][m][1] = a1; } }
                asm volatile("" ::: "memory"); }
    }
    DI void operator()(const f32x4 (&acc)[2][2][4][2], const pg8::Unit& u, int wr, int wc, int fr, int fq) const {
        const int row0 = u.pm * 256 + wr * 64 + fr, col0 = u.pn * 256 + wc * 32 + 8 * fq;
#pragma unroll
        for (int ai = 0; ai < 2; ++ai) { u32x4 gws[4][2];
#pragma unroll
            for (int m = 0; m < 4; ++m)
#pragma unroll
                for (int bj = 0; bj < 2; ++bj) gws[m][bj] = *(const u32x4*)(G + (size_t)(row0 + ai * 128 + m * 16) * NG + 2 * 1024 + col0 + bj * 128);
#pragma unroll
            for (int m = 0; m < 4; ++m) { const size_t r = (size_t)(row0 + ai * 128 + m * 16);
#pragma unroll
                for (int bj = 0; bj < 2; ++bj) { const u32x4 gw = gws[m][bj];
                    const f32x4 a0 = acc[ai][bj][m][0], a1 = acc[ai][bj][m][1];
                    u32x4 w; w.x = pk2(bflo(gw.x) * a0[0], bfhi(gw.x) * a0[1]); w.y = pk2(bflo(gw.y) * a0[2], bfhi(gw.y) * a0[3]); w.z = pk2(bflo(gw.z) * a1[0], bfhi(gw.z) * a1[1]); w.w = pk2(bflo(gw.w) * a1[2], bfhi(gw.w) * a1[3]);
                    *(u32x4*)(MG + r * 1024 + col0 + bj * 128) = w; } }
            asm volatile("" ::: "memory"); }
    }
};
struct EpiRes {
    static constexpr bool PERM = false, AFTER_DRAIN = false, HAS_MID = false;
    const float* xsrc; float* xdst; const float* csrc; float* cdst; const float* mod; int colmajor; float pscale; int b;
    DI void operator()(const f32x4 (&acc)[2][2][4][2], const pg8::Unit& u, int wr, int wc, int fr, int fq) const {
        const int rowt = u.pm * 256; const bool isx = rowt < 4096; const int bb = isx ? b : 8;
        const float* mrow = mod + bb * 6144; const int col0 = u.pn * 256 + wc * 32 + 4 * fq;
        f32x4 mv[2][2];
#pragma unroll
        for (int bj = 0; bj < 2; ++bj)
#pragma unroll
            for (int n = 0; n < 2; ++n) mv[bj][n] = *(const f32x4*)(mrow + col0 + bj * 128 + n * 16) * pscale;
#pragma unroll
        for (int ai = 0; ai < 2; ++ai)
#pragma unroll
            for (int mp = 0; mp < 1; ++mp) { const float* src[4]; float* dst[4]; f32x4 xin[4][2][2];
#pragma unroll
                for (int mm = 0; mm < 4; ++mm) { const int m = 4 * mp + mm; const int r = rowt + ai * 128 + wr * 64 + m * 16 + fr;
                    if (isx) { const int p = r; const int t = colmajor ? (((p & 63) << 6) | (p >> 6)) : p; const size_t off = ((size_t)(b * 4096 + t)) * 1024 + col0; src[mm] = xsrc + off; dst[mm] = xdst + off; }
                    else { const size_t off = (size_t)(b * 256 + (r - 4096)) * 1024 + col0; src[mm] = csrc + off; dst[mm] = cdst + off; }
#pragma unroll
                    for (int bj = 0; bj < 2; ++bj)
#pragma unroll
                        for (int n = 0; n < 2; ++n) xin[mm][bj][n] = *(const f32x4*)(src[mm] + bj * 128 + n * 16); }
#pragma unroll
                for (int mm = 0; mm < 4; ++mm) { const int m = 4 * mp + mm;
#pragma unroll
                    for (int bj = 0; bj < 2; ++bj)
#pragma unroll
                        for (int n = 0; n < 2; ++n) *(f32x4*)(dst[mm] + bj * 128 + n * 16) = xin[mm][bj][n] + mv[bj][n] * acc[ai][bj][m][n]; }
                asm volatile("" ::: "memory"); }
    }
};
struct Epi5 {
    static constexpr bool PERM = true, AFTER_DRAIN = false, HAS_MID = false;
    bf16_t* H;
    DI void operator()(const f32x4 (&acc)[2][2][4][2], const pg8::Unit& u, int wr, int wc, int fr, int fq) const {
        const int row0 = u.pm * 256 + wr * 64 + fr, col0 = u.pn * 128 + wc * 32 + 8 * fq;
#pragma unroll
        for (int ai = 0; ai < 2; ++ai)
#pragma unroll
            for (int m = 0; m < 4; ++m) { bf16_t* rowp = H + (size_t)(row0 + ai * 128 + m * 16) * FF + col0;
                f32x4 v0, v1;
#pragma unroll
                for (int j = 0; j < 4; ++j) { v0[j] = silu_(acc[ai][0][m][0][j]) * acc[ai][1][m][0][j]; v1[j] = silu_(acc[ai][0][m][1][j]) * acc[ai][1][m][1][j]; }
                u32x4 w; w.x = pk2(v0[0], v0[1]); w.y = pk2(v0[2], v0[3]); w.z = pk2(v1[0], v1[1]); w.w = pk2(v1[2], v1[3]);
                *(u32x4*)rowp = w; }
    }
};
template <class Epi> DI void run_gemm(LAS unsigned char* lds, const bf16_t* A, const bf16_t* Bt, int M, int N, int K, const Epi& E, int gr, int gs) {
    pg8::Gemm g{A, Bt, M, N, K}; pg8::StaticOrder S; S.init(M, N, gs, gr);
    pg8::gemm_phase<Epi, pg8::StaticOrder, PG8_ALIGN_V, PG8_SP2_V>(lds, g, S, E);
}

DI void phase_mod(const KArgs& a, LAS unsigned char* lds, float* MOD, float* LB) {
    LAS float* SC = (LAS float*)lds; LAS float* RED = SC + 9 * 1024;
    const int tid = otid(), lane = tid & 63, w = tid >> 6;
    for (int i = tid; i < 9 * 1024; i += 512) { const int r = i >> 10, k = i & 1023; const float v = r < 8 ? a.in[1][r * 1024 + k] : a.in[3][k]; SC[i] = v / (1.f + __expf(-v)); }
    __syncthreads();
    for (int u = blockIdx.x; u < 4 * 96; u += gridDim.x) {
        const int l = u / 96, n0 = (u % 96) * 64;
        const float* W = a.in[4] + (size_t)l * 1024 * 6144 + n0 + lane;
        float acc[9];
#pragma unroll
        for (int r = 0; r < 9; ++r) acc[r] = 0.f;
#pragma unroll 16
        for (int k = w * 128; k < w * 128 + 128; ++k) { const float wv = W[(size_t)k * 6144];
#pragma unroll
            for (int r = 0; r < 9; ++r) acc[r] += SC[r * 1024 + k] * wv; }
#pragma unroll
        for (int r = 0; r < 9; ++r) RED[(w * 9 + r) * 64 + lane] = acc[r];
        __syncthreads();
        for (int i = tid; i < 9 * 64; i += 512) { const int r = i >> 6, c = i & 63; float s = 0.f;
#pragma unroll
            for (int ww = 0; ww < 8; ++ww) s += RED[(ww * 9 + r) * 64 + c];
            MOD[((size_t)l * 9 + r) * 6144 + n0 + c] = s + a.in[5][l * 6144 + n0 + c]; }
        __syncthreads();
    }
    for (int i = blockIdx.x * 512 + tid; i < 1024; i += gridDim.x * 512) {
        const float r0 = a.in[9][i], r1 = a.in[9][1024 + i], r2 = a.in[9][2048 + i], r3 = a.in[9][3072 + i];
        const float mx = fmaxf(fmaxf(r0, r1), fmaxf(r2, r3));
        const float e0 = __expf(r0 - mx), e1 = __expf(r1 - mx), e2 = __expf(r2 - mx), e3 = __expf(r3 - mx), inv = 1.f / (e0 + e1 + e2 + e3);
        LB[i] = 0.f; LB[1024 + i] = e1 * inv; LB[2048 + i] = (e1 + e2) * inv; LB[3072 + i] = (e1 + e2 + e3) * inv;
    }
}
DI int map_in(int n) {
    if (n < 1024) return n;
    if (n < 1536) return 3584 + (n - 1024);
    if (n < 2560) return 1024 + (n - 1536);
    if (n < 2816) return 2048 + (n - 2560);
    if (n < 3072) return 2304 + (n - 2816);
    if (n < 3584) return 2560 + (n - 3072);
    if (n < 4096) return 4096 + (n - 3584);
    if (n < 4112) return 5120 + (n - 4096);
    if (n < 4624) return 3072 + (n - 4112);
    if (n < 5136) return 4608 + (n - 4624);
    return 5376 + (n - 5136);
}
DI int map_ffn(int n) { return n < FF ? ((n >> 7) * 256 + (n & 127)) : (((n - FF) >> 7) * 256 + 128 + ((n - FF) & 127)); }
template <int MAP> DI void conv_item(const float* W, int K, int N, bf16_t* WT, LAS float* scr, int item, int lane, int ldk = 0) {
    if (ldk == 0) ldk = K;
    const int nblk = (N + 31) / 32, kb = item / nblk, nb = item % nblk, k0 = 64 * kb, n0 = 32 * nb;
    const int nn = n0 + (lane & 31); const bool ok = nn < N;
#pragma unroll 8
    for (int i = 0; i < 32; ++i) { const int kk = 2 * i + (lane >> 5); scr[kk * 33 + (lane & 31)] = ok ? W[(size_t)(k0 + kk) * N + nn] : 0.f; }
    asm volatile("s_waitcnt lgkmcnt(0)" ::: "memory");
    const int c = lane & 7;
#pragma unroll
    for (int j = 0; j < 4; ++j) { const int nl = (lane >> 3) + 8 * j, n = n0 + nl;
        if (n < N) { const LAS float* s = scr + (8 * c) * 33 + nl;
            u32x4 o; o.x = pk2(s[0 * 33], s[1 * 33]); o.y = pk2(s[2 * 33], s[3 * 33]); o.z = pk2(s[4 * 33], s[5 * 33]); o.w = pk2(s[6 * 33], s[7 * 33]);
            const int dr = MAP == 1 ? map_in(n) : (MAP == 2 ? map_ffn(n) : n);
            *(u32x4*)(WT + (size_t)dr * ldk + k0 + 8 * c) = o; } }
    asm volatile("s_waitcnt lgkmcnt(0)" ::: "memory");
}
DI void phase_conv(const KArgs& a, LAS unsigned char* lds, int l, unsigned char* wsw, float* BIAS) {
    const int tid = otid(), lane = tid & 63, w = tid >> 6;
    LAS float* scr = (LAS float*)(lds + w * 16384);
    const int gw = blockIdx.x * 8 + w, NGW = gridDim.x * 8;
    constexpr int I_IN = 16 * 257, I_BR = 8 * 32, I_O = 16 * 32, I_FI = 16 * 176, I_FO = 44 * 32;
    constexpr int NIT = I_IN + 3 * I_BR + I_O + I_FI + I_FO;
    for (int it = gw; it < NIT; it += NGW) {
        int r = it;
        if (r < I_IN) { conv_item<1>(a.in[7] + (size_t)l * 1024 * NIN, 1024, NIN, (bf16_t*)(wsw + W_W1), scr, r, lane); continue; } r -= I_IN;
        if (r < 3 * I_BR) { const int n = r / I_BR; conv_item<0>(a.in[17] + ((size_t)l * 3 + n) * 512 * 1024, 512, 1024, (bf16_t*)(wsw + W_BR) + (size_t)n * 512, scr, r % I_BR, lane, 1536); continue; } r -= 3 * I_BR;
        if (r < I_O) { conv_item<0>(a.in[18] + (size_t)l * 1024 * 1024, 1024, 1024, (bf16_t*)(wsw + W_O), scr, r, lane); continue; } r -= I_O;
        if (r < I_FI) { conv_item<2>(a.in[20] + (size_t)l * 1024 * 2 * FF, 1024, 2 * FF, (bf16_t*)(wsw + W_FI), scr, r, lane); continue; } r -= I_FI;
        conv_item<0>(a.in[21] + (size_t)l * FF * 1024, FF, 1024, (bf16_t*)(wsw + W_FO), scr, r, lane);
    }
    for (int i = blockIdx.x * 512 + tid; i < NIN; i += gridDim.x * 512) BIAS[(size_t)l * NW1 + map_in(i)] = a.in[8][(size_t)l * NIN + i];
    for (int i = blockIdx.x * 512 + tid; i < 240; i += gridDim.x * 512) BIAS[(size_t)l * NW1 + 5136 + i] = 0.f;
}
DI void phase_conv_q(const KArgs& a, LAS unsigned char* lds, int l, unsigned char* wsw, float* BIAS, unsigned* q) {
    const int tid = otid(), lane = tid & 63, w = tid >> 6;
    LAS float* scr = (LAS float*)(lds + w * 16384);
    constexpr int I_IN = 16 * 257, I_BR = 8 * 32, I_O = 16 * 32, I_FI = 16 * 176, I_FO = 44 * 32;
    constexpr int NIT = I_IN + 3 * I_BR + I_O + I_FI + I_FO;
    for (;;) {
        unsigned itv = 0u; if (lane == 0) itv = __hip_atomic_fetch_add(q, 1u, __ATOMIC_RELAXED, __HIP_MEMORY_SCOPE_AGENT);
        const int it = __builtin_amdgcn_readfirstlane((int)itv);
        if (it >= NIT + 18) break;
        int r = it;
        if (r >= NIT) { r -= NIT;
            if (r < 17) {
#pragma unroll
                for (int k = 0; k < 8; ++k) { const int i = r * 512 + k * 64 + lane; if (i < NIN) BIAS[(size_t)l * NW1 + map_in(i)] = a.in[8][(size_t)l * NIN + i]; } }
            else {
#pragma unroll
                for (int k = 0; k < 4; ++k) { const int i = k * 64 + lane; if (i < 240) BIAS[(size_t)l * NW1 + 5136 + i] = 0.f; } }
            continue; }
        if (r < I_IN) { conv_item<1>(a.in[7] + (size_t)l * 1024 * NIN, 1024, NIN, (bf16_t*)(wsw + W_W1), scr, r, lane); continue; } r -= I_IN;
        if (r < 3 * I_BR) { const int n = r / I_BR; conv_item<0>(a.in[17] + ((size_t)l * 3 + n) * 512 * 1024, 512, 1024, (bf16_t*)(wsw + W_BR) + (size_t)n * 512, scr, r % I_BR, lane, 1536); continue; } r -= 3 * I_BR;
        if (r < I_O) { conv_item<0>(a.in[18] + (size_t)l * 1024 * 1024, 1024, 1024, (bf16_t*)(wsw + W_O), scr, r, lane); continue; } r -= I_O;
        if (r < I_FI) { conv_item<2>(a.in[20] + (size_t)l * 1024 * 2 * FF, 1024, 2 * FF, (bf16_t*)(wsw + W_FI), scr, r, lane); continue; } r -= I_FI;
        conv_item<0>(a.in[21] + (size_t)l * FF * 1024, FF, 1024, (bf16_t*)(wsw + W_FO), scr, r, lane);
    }
}
DI void norm_row(const float* src, const float* lnw, const float* shift, const float* scale, bf16_t* dst, int lane) {
    const f32x4* xr = (const f32x4*)src + lane; f32x4 v[4]; float s = 0.f;
#pragma unroll
    for (int j = 0; j < 4; ++j) { v[j] = xr[64 * j]; s += (v[j].x * v[j].x + v[j].y * v[j].y) + (v[j].z * v[j].z + v[j].w * v[j].w); }
    const float rstd = rsqrtf(wave_sum(s) * (1.f / D) + EPS);
#pragma unroll
    for (int j = 0; j < 4; ++j) { const int c = 4 * lane + 256 * j; const f32x4 w = *(const f32x4*)(lnw + c), sh = *(const f32x4*)(shift + c), sc = *(const f32x4*)(scale + c);
        const f32x4 y = v[j] * rstd * w * (sc + 1.f) + sh; u32x2 o; o.x = pk2(y.x, y.y); o.y = pk2(y.z, y.w); *(u32x2*)(dst + c) = o; }
}
DI const float* src_row(int m, int b, const float* xs, const float* cs, int colmajor, int& modrow) {
    if (m < 4096) { const int p = m, t = colmajor ? (((p & 63) << 6) | (p >> 6)) : p; modrow = b; return xs + ((size_t)(b * 4096 + t)) * 1024; }
    modrow = 8; return cs + (size_t)(b * 256 + (m - 4096)) * 1024;
}
DI void phase_norm(const float* xs, const float* cs, const float* lnw, const float* modl, int ksh, int ksc, int colmajor, bf16_t* AS, int Mrows, int b, int gr, int gs) {
    const int tid = otid(); const int lane = tid & 63, gw = gr * 8 + (tid >> 6), NGW = gs * 8;
    f32x4 wf[4], sf[4], nv[4]; int curmr = -1; int m = gw;
    if (m < Mrows) { int mr; const f32x4* xr = (const f32x4*)src_row(m, b, xs, cs, colmajor, mr) + lane;
#pragma unroll
        for (int j = 0; j < 4; ++j) nv[j] = __builtin_nontemporal_load(&xr[64 * j]); }
    while (m < Mrows) {
        f32x4 v[4];
#pragma unroll
        for (int j = 0; j < 4; ++j) v[j] = nv[j];
        const int mr = (m < 4096) ? b : 8, mn = m + NGW;
        if (mn < Mrows) { int mr2; const f32x4* xr = (const f32x4*)src_row(mn, b, xs, cs, colmajor, mr2) + lane;
#pragma unroll
            for (int j = 0; j < 4; ++j) nv[j] = __builtin_nontemporal_load(&xr[64 * j]); }
        if (mr != curmr) { curmr = mr;
#pragma unroll
            for (int j = 0; j < 4; ++j) { const int c = 4 * lane + 256 * j; wf[j] = *(const f32x4*)(lnw + c) * (*(const f32x4*)(modl + mr * 6144 + ksc * 1024 + c) + 1.f); sf[j] = *(const f32x4*)(modl + mr * 6144 + ksh * 1024 + c); } }
        float s = 0.f;
#pragma unroll
        for (int j = 0; j < 4; ++j) s += (v[j].x * v[j].x + v[j].y * v[j].y) + (v[j].z * v[j].z + v[j].w * v[j].w);
        const float rstd = rsqrtf(wave_sum(s) * (1.f / D) + EPS);
        bf16_t* dst = AS + (size_t)m * 1024;
#pragma unroll
        for (int j = 0; j < 4; ++j) { const f32x4 y = v[j] * rstd * wf[j] + sf[j]; u32x2 o; o.x = pk2(y.x, y.y); o.y = pk2(y.z, y.w); *(u32x2*)(dst + 4 * lane + 256 * j) = o; }
        m = mn;
    }
}
DI void phase_fin(const float* xs, const float* cs, const float* lnw, const float* modl, int colmajor, bf16_t* AS, bf16_t* SL, bf16_t* BR, const float* hgn, const float* mln, int Mrows, int b, int gr, int gs) {
    const int tid = otid(); const int lane = tid & 63, gw = gr * 8 + (tid >> 6), NGW = gs * 8;
    const int cb = (16 * lane) & 511; const float* nwp = (lane < 32 ? hgn : mln) + cb;
    f32x4 nw4[4];
#pragma unroll
    for (int j = 0; j < 4; ++j) nw4[j] = *(const f32x4*)(nwp + 4 * j);
    f32x4 wf[4], sf[4]; int curmr = -1; int m = gw;
    u32x4 ns0, ns1, ng0, ng1, nsl, ng2; f32x4 nv[4];
#define FIN_LOAD(mm) do { const bf16_t* ap = AS + (size_t)(mm) * 1024 + 16 * lane; ns0 = *(const u32x4*)ap; ns1 = *(const u32x4*)(ap + 8); const bf16_t* gp_ = BR + (size_t)(mm) * 1536 + 16 * lane; ng0 = *(const u32x4*)gp_; ng1 = *(const u32x4*)(gp_ + 8); \
        nsl = *(const u32x4*)(SL + (size_t)(mm) * 512 + 8 * lane); ng2 = *(const u32x4*)(BR + (size_t)(mm) * 1536 + 1024 + 8 * lane); \
        int mr_; const f32x4* xr = (const f32x4*)src_row((mm), b, xs, cs, colmajor, mr_) + lane; _Pragma("unroll") for (int j = 0; j < 4; ++j) nv[j] = __builtin_nontemporal_load(&xr[64 * j]); } while (0)
    if (m < Mrows) FIN_LOAD(m);
    while (m < Mrows) {
        const u32x4 s0 = ns0, s1 = ns1, g0 = ng0, g1 = ng1, sl = nsl, g2 = ng2; f32x4 v[4];
#pragma unroll
        for (int j = 0; j < 4; ++j) v[j] = nv[j];
        const int mr = (m < 4096) ? b : 8, mn = m + NGW;
        if (mn < Mrows) FIN_LOAD(mn);
        if (mr != curmr) { curmr = mr;
#pragma unroll
            for (int j = 0; j < 4; ++j) { const int c = 4 * lane + 256 * j; wf[j] = *(const f32x4*)(lnw + c) * (*(const f32x4*)(modl + mr * 6144 + 1024 + c) + 1.f); sf[j] = *(const f32x4*)(modl + mr * 6144 + c); } }
        {
            float sv[16] = { bflo(s0.x), bfhi(s0.x), bflo(s0.y), bfhi(s0.y), bflo(s0.z), bfhi(s0.z), bflo(s0.w), bfhi(s0.w), bflo(s1.x), bfhi(s1.x), bflo(s1.y), bfhi(s1.y), bflo(s1.z), bfhi(s1.z), bflo(s1.w), bfhi(s1.w) };
            float ss = 0.f;
#pragma unroll
            for (int j = 0; j < 16; ++j) ss += sv[j] * sv[j];
            ss += __shfl_xor(ss, 1); ss += __shfl_xor(ss, 2); ss += __shfl_xor(ss, 4);
            const float rstd = rsqrtf(ss * (1.f / 128.f) + EPS);
            const float g[16] = { bflo(g0.x), bfhi(g0.x), bflo(g0.y), bfhi(g0.y), bflo(g0.z), bfhi(g0.z), bflo(g0.w), bfhi(g0.w), bflo(g1.x), bfhi(g1.x), bflo(g1.y), bfhi(g1.y), bflo(g1.z), bfhi(g1.z), bflo(g1.w), bfhi(g1.w) };
            float o[16];
#pragma unroll
            for (int j = 0; j < 16; ++j) o[j] = sv[j] * rstd * nw4[j >> 2][j & 3] * g[j];
            u32x4 w0, w1; w0.x = pk2(o[0], o[1]); w0.y = pk2(o[2], o[3]); w0.z = pk2(o[4], o[5]); w0.w = pk2(o[6], o[7]); w1.x = pk2(o[8], o[9]); w1.y = pk2(o[10], o[11]); w1.z = pk2(o[12], o[13]); w1.w = pk2(o[14], o[15]);
            bf16_t* gp = BR + (size_t)m * 1536 + 16 * lane; ((u32x4*)gp)[0] = w0; ((u32x4*)gp)[1] = w1;
        }
        {
            u32x4 w; w.x = pk2(bflo(sl.x) * bflo(g2.x), bfhi(sl.x) * bfhi(g2.x)); w.y = pk2(bflo(sl.y) * bflo(g2.y), bfhi(sl.y) * bfhi(g2.y)); w.z = pk2(bflo(sl.z) * bflo(g2.z), bfhi(sl.z) * bfhi(g2.z)); w.w = pk2(bflo(sl.w) * bflo(g2.w), bfhi(sl.w) * bfhi(g2.w));
            *(u32x4*)(BR + (size_t)m * 1536 + 1024 + 8 * lane) = w;
        }
        {
            float s = 0.f;
#pragma unroll
            for (int j = 0; j < 4; ++j) s += (v[j].x * v[j].x + v[j].y * v[j].y) + (v[j].z * v[j].z + v[j].w * v[j].w);
            const float rstd = rsqrtf(wave_sum(s) * (1.f / D) + EPS);
            bf16_t* dst = AS + (size_t)m * 1024;
#pragma unroll
            for (int j = 0; j < 4; ++j) { const f32x4 y = v[j] * rstd * wf[j] + sf[j]; u32x2 o2; o2.x = pk2(y.x, y.y); o2.y = pk2(y.z, y.w); *(u32x2*)(dst + 4 * lane + 256 * j) = o2; }
        }
        m = mn;
    }
#undef FIN_LOAD
}
DI void phase_final(float* out, const float* fw, int gr, int gs) {
    const int tid = otid(); const int lane = tid & 63, gw = gr * 8 + (tid >> 6), NGW = gs * 8;
    f32x4 wv[4], nv[4];
#pragma unroll
    for (int j = 0; j < 4; ++j) wv[j] = *(const f32x4*)(fw + 4 * lane + 256 * j);
    int m = gw;
    if (m < 4096) { const f32x4* xr = (const f32x4*)(out + (size_t)m * 1024) + lane;
#pragma unroll
        for (int j = 0; j < 4; ++j) nv[j] = __builtin_nontemporal_load(&xr[64 * j]); }
    while (m < 4096) { f32x4 v[4]; float s = 0.f;
#pragma unroll
        for (int j = 0; j < 4; ++j) { v[j] = nv[j]; s += (v[j].x * v[j].x + v[j].y * v[j].y) + (v[j].z * v[j].z + v[j].w * v[j].w); }
        const int mn = m + NGW;
        if (mn < 4096) { const f32x4* xr = (const f32x4*)(out + (size_t)mn * 1024) + lane;
#pragma unroll
            for (int j = 0; j < 4; ++j) nv[j] = __builtin_nontemporal_load(&xr[64 * j]); }
        const float rstd = rsqrtf(wave_sum(s) * (1.f / D) + EPS);
        f32x4* xo = (f32x4*)(out + (size_t)m * 1024) + lane;
#pragma unroll
        for (int j = 0; j < 4; ++j) xo[64 * j] = v[j] * rstd * wv[j];
        m = mn; }
}

struct ScanArgs { const bf16_t* P; const float* MLG; bf16_t* AS; bf16_t* SL; const float* convw; const float* convb; const float* gw; const float* gb; const float* lam; int last; };
DI void chunk_geom(int j, int b, int dir, int& rowbase, int& pos0, int& slen, bool& first, bool& isx) {
    isx = j >= 4; const int cj = isx ? j - 4 : j, nch = isx ? 64 : 4, pc = dir ? nch - 1 - cj : cj;
    pos0 = pc * 64; slen = nch * 64; rowbase = (isx ? 0 : 4096) + pc * 64; first = cj < nch / 2; (void)b;
}
DI void out_rmw4(bf16_t* p, f32x4 v, bool first) {
    if (!first) { const unsigned long long w = __hip_atomic_load((unsigned long long*)p, __ATOMIC_RELAXED, __HIP_MEMORY_SCOPE_AGENT); const unsigned lo = (unsigned)w, hi = (unsigned)(w >> 32);
        v[0] += bflo(lo); v[1] += bfhi(lo); v[2] += bflo(hi); v[3] += bfhi(hi); }
    u32x2 o; o.x = pk2(v[0], v[1]); o.y = pk2(v[2], v[3]); *(u32x2*)p = o;
}
DI unsigned long long ld8_coh(const bf16_t* p) { return __hip_atomic_load((const unsigned long long*)p, __ATOMIC_RELAXED, __HIP_MEMORY_SCOPE_AGENT); }
DI void out_put4(bf16_t* p, f32x4 v, int mode, unsigned long long pre) {
    if (mode != 0) { const unsigned long long w = pre; const unsigned lo = (unsigned)w, hi = (unsigned)(w >> 32);
        v[0] += bflo(lo); v[1] += bfhi(lo); v[2] += bflo(hi); v[3] += bfhi(hi); }
    u32x2 o; o.x = pk2(v[0], v[1]); o.y = pk2(v[2], v[3]); *(u32x2*)p = o;
}
DI int pre_mode(bool first, int jn) { (void)jn; return first ? 0 : 1; }
DI bool late_pre(int jn) { return jn == 2 || jn == 36; }
constexpr int NSTEP = 68;
constexpr float ECLAMP = 120.f;

#define LBAR() do { asm volatile("s_waitcnt lgkmcnt(0)" ::: "memory"); __builtin_amdgcn_s_barrier(); asm volatile("" ::: "memory"); } while (0)
DI void scan_hgrn2(const ScanArgs& A, LAS unsigned char* lds, int unit) {
    const int tid = otid(), dir = tid >> 8, ht = tid & 255, hw = ht >> 6, lane = tid & 63, fr = lane & 15, fq = lane >> 4;
    const int b = 0, h = (unit >> 2) & 3, vs = unit & 3;
    LAS unsigned char* L = lds + dir * 76800;
    LAS bf16_t* Qt = (LAS bf16_t*)L;
    LAS bf16_t* Kt = Qt + 64 * 136;
    LAS bf16_t* KtT = Kt + 64 * 136;
    LAS bf16_t* Vt = KtT + 128 * 72;
    LAS bf16_t* Sc = Vt + 32 * 72;
    LAS bf16_t* Sb = Sc + 64 * 72;
    LAS float* GT = (LAS float*)Sc;
    LAS float* E2 = (LAS float*)(Sb + 32 * 136);
    LAS float* DEC = E2 + 128;
    const bf16_t* Pq = A.P + h * 128 + 2 * lane;
    const bf16_t* Pf = A.P + 1024 + dir * 512 + h * 128 + 2 * lane;
    const bf16_t* Pv = A.P + 512 + h * 128 + vs * 32 + (ht & 3) * 8;
    unsigned qw[16], fw[16]; u32x4 vv; unsigned long long pr[2] = {0ull, 0ull}; int pmode = 0;
    bf16_t* const opb = A.AS + h * 128 + vs * 32 + 4 * fq;
    f32x4 S[2][2];
#pragma unroll
    for (int a = 0; a < 2; ++a)
#pragma unroll
        for (int c = 0; c < 2; ++c) S[a][c] = (f32x4){0.f, 0.f, 0.f, 0.f};
    int rowbase, pos0, slen; bool first, isx;
    chunk_geom(0, b, dir, rowbase, pos0, slen, first, isx);
#define HG_LOAD() do { \
        _Pragma("unroll") for (int i = 0; i < 16; ++i) { const int t = 16 * hw + i; const size_t r = (size_t)(rowbase + (dir ? 63 - t : t)) * NP; qw[i] = *(const unsigned*)(Pq + r); fw[i] = *(const unsigned*)(Pf + r); } \
        { const int t = ht >> 2; vv = *(const u32x4*)(Pv + (size_t)(rowbase + (dir ? 63 - t : t)) * NP); } \
        if (pmode == 1 && !late_pre(jnx)) { const int t = 16 * hw + fr; const bf16_t* op = opb + (size_t)(rowbase + (dir ? 63 - t : t)) * 1024; pr[0] = ld8_coh(op); pr[1] = ld8_coh(op + 16); } } while (0)
    int jnx = 0;
    pmode = (A.last && !isx) ? 0 : pre_mode(first, 0);
    HG_LOAD();
    for (int j = 0; j < NSTEP; ++j) {
        const int orow = rowbase; const bool owrite = !(A.last && !isx); const int omode = pmode;
        if (late_pre(j) && pmode == 1) { const int t = 16 * hw + fr; const bf16_t* op = opb + (size_t)(rowbase + (dir ? 63 - t : t)) * 1024; pr[0] = ld8_coh(op); pr[1] = ld8_coh(op + 16); }
        unsigned long long opr0 = pr[0], opr1 = pr[1];
        asm volatile("" : "+v"(opr0), "+v"(opr1));
        float c0[16], c1[16]; float r0 = 0.f, r1 = 0.f;
#pragma unroll
        for (int i = 0; i < 16; ++i) { r0 += bflo(fw[i]); r1 += bfhi(fw[i]); c0[i] = r0; c1[i] = r1; }
        GT[hw * 128 + 2 * lane] = r0; GT[hw * 128 + 2 * lane + 1] = r1;
        { const int t = ht >> 2, v0 = (ht & 3) * 8; const unsigned vw[4] = {vv.x, vv.y, vv.z, vv.w};
#pragma unroll
            for (int e = 0; e < 4; ++e) { Vt[(v0 + 2 * e) * 72 + t] = (bf16_t)(vw[e] & 0xffffu); Vt[(v0 + 2 * e + 1) * 72 + t] = (bf16_t)(vw[e] >> 16); } }
        LBAR();
        {
            const float g00 = GT[2 * lane], g01 = GT[128 + 2 * lane], g02 = GT[256 + 2 * lane], g03 = GT[384 + 2 * lane];
            const float g10 = GT[2 * lane + 1], g11 = GT[128 + 2 * lane + 1], g12 = GT[256 + 2 * lane + 1], g13 = GT[384 + 2 * lane + 1];
            const float ref0 = g00 + g01, ref1 = g10 + g11, tot0 = ref0 + g02 + g03, tot1 = ref1 + g12 + g13;
            const float pre0 = hw == 0 ? 0.f : (hw == 1 ? g00 : (hw == 2 ? ref0 : ref0 + g02));
            const float pre1 = hw == 0 ? 0.f : (hw == 1 ? g10 : (hw == 2 ? ref1 : ref1 + g12));
            unsigned kp0[8], kp1[8];
            const float bs0 = fminf(fmaxf(pre0 - ref0, -ECLAMP), ECLAMP), bs1 = fminf(fmaxf(pre1 - ref1, -ECLAMP), ECLAMP);
            const float sq0 = ex2(bs0), sk0 = ex2(-bs0), sq1 = ex2(bs1), sk1 = ex2(-bs1);
            float E0 = 1.f, E1 = 1.f;
#pragma unroll
            for (int i = 0; i < 16; ++i) {
                const int t = 16 * hw + i;
                const float f0 = ex2(bflo(fw[i])), f1 = ex2(bfhi(fw[i]));
                E0 *= f0; E1 *= f1;
                const float eq0 = sq0 * E0, eq1 = sq1 * E1;
                const float ek0 = fminf(sk0 * rcpf_(E0), 1.3e36f), ek1 = fminf(sk1 * rcpf_(E1), 1.3e36f);
                const float q0 = bflo(qw[i]) * eq0, q1 = bfhi(qw[i]) * eq1;
                const float k0 = (1.f - f0) * ek0, k1 = (1.f - f1) * ek1;
                *(LAS unsigned*)(Qt + t * 136 + 2 * lane) = pk2(q0, q1);
                const unsigned kk = pk2(k0, k1);
                *(LAS unsigned*)(Kt + t * 136 + 2 * lane) = kk;
                if (i & 1) { kp0[i >> 1] |= (kk << 16); kp1[i >> 1] |= (kk & 0xffff0000u); } else { kp0[i >> 1] = kk & 0xffffu; kp1[i >> 1] = kk >> 16; }
            }
            { u32x4 w; w.x = kp0[0]; w.y = kp0[1]; w.z = kp0[2]; w.w = kp0[3]; *(LAS u32x4*)(KtT + (2 * lane) * 72 + 16 * hw) = w; w.x = kp0[4]; w.y = kp0[5]; w.z = kp0[6]; w.w = kp0[7]; *(LAS u32x4*)(KtT + (2 * lane) * 72 + 16 * hw + 8) = w;
              w.x = kp1[0]; w.y = kp1[1]; w.z = kp1[2]; w.w = kp1[3]; *(LAS u32x4*)(KtT + (2 * lane + 1) * 72 + 16 * hw) = w; w.x = kp1[4]; w.y = kp1[5]; w.z = kp1[6]; w.w = kp1[7]; *(LAS u32x4*)(KtT + (2 * lane + 1) * 72 + 16 * hw + 8) = w; }
            if (hw == 0) { E2[2 * lane] = ex2(tot0 - ref0); E2[2 * lane + 1] = ex2(tot1 - ref1); DEC[2 * lane] = ex2(tot0); DEC[2 * lane + 1] = ex2(tot1); }
#pragma unroll
            for (int a = 0; a < 2; ++a) { const int kb = 16 * (2 * hw + a) + 4 * fq; float sc4[4];
#pragma unroll
                for (int i = 0; i < 4; ++i) sc4[i] = ex2(GT[kb + i] + GT[128 + kb + i]);
#pragma unroll
                for (int c = 0; c < 2; ++c) { u32x2 w; w.x = pk2(S[a][c][0] * sc4[0], S[a][c][1] * sc4[1]); w.y = pk2(S[a][c][2] * sc4[2], S[a][c][3] * sc4[3]); *(LAS u32x2*)(Sb + (16 * c + fr) * 136 + kb) = w; } }
        }
        LBAR();
        if (j + 1 < NSTEP) { chunk_geom(j + 1, b, dir, rowbase, pos0, slen, first, isx); pmode = (A.last && !isx) ? 0 : pre_mode(first, j + 1); jnx = j + 1; HG_LOAD(); }
#pragma unroll
        for (int st = 0; st < 4; ++st) {
            f32x4 acc = (f32x4){0.f, 0.f, 0.f, 0.f};
            if (st <= hw) {
#pragma unroll
                for (int kk = 0; kk < 4; ++kk) acc = mfma16(ldfrag(Kt, 136, 16 * st, 32 * kk, lane), ldfrag(Qt, 136, 16 * hw, 32 * kk, lane), acc);
                if (st == hw) {
#pragma unroll
                    for (int i = 0; i < 4; ++i) acc[i] = (4 * fq + i <= fr) ? acc[i] : 0.f;
                }
            }
            u32x2 w; w.x = pk2(acc[0], acc[1]); w.y = pk2(acc[2], acc[3]);
            *(LAS u32x2*)(Sc + (16 * hw + fr) * 72 + 16 * st + 4 * fq) = w;
        }
        {
            const int t = 16 * hw + fr; bf16_t* op = opb + (size_t)(orow + (dir ? 63 - t : t)) * 1024;
#pragma unroll
            for (int c = 0; c < 2; ++c) { f32x4 acc = (f32x4){0.f, 0.f, 0.f, 0.f};
#pragma unroll
                for (int ks = 0; ks < 2; ++ks) acc = mfma16(ldfrag(Vt, 72, 16 * c, 32 * ks, lane), ldfrag(Sc, 72, 16 * hw, 32 * ks, lane), acc);
#pragma unroll
                for (int kk = 0; kk < 4; ++kk) acc = mfma16(ldfrag(Sb, 136, 16 * c, 32 * kk, lane), ldfrag(Qt, 136, 16 * hw, 32 * kk, lane), acc);
                if (owrite) out_put4(op + 16 * c, acc, omode, c == 0 ? opr0 : opr1); }
        }
#pragma unroll
        for (int a = 0; a < 2; ++a) { const int kb = 16 * (2 * hw + a);
            f32x4 dk, ek;
#pragma unroll
            for (int i = 0; i < 4; ++i) { dk[i] = DEC[kb + 4 * fq + i]; ek[i] = E2[kb + 4 * fq + i]; }
#pragma unroll
            for (int c = 0; c < 2; ++c) { f32x4 d = (f32x4){0.f, 0.f, 0.f, 0.f};
#pragma unroll
                for (int ks = 0; ks < 2; ++ks) d = mfma16(ldfrag(KtT, 72, kb, 32 * ks, lane), ldfrag(Vt, 72, 16 * c, 32 * ks, lane), d);
                S[a][c] = S[a][c] * dk + d * ek; } }
        if (j == 1 || j == 35) asm volatile("s_waitcnt vmcnt(0)" ::: "memory");
        LBAR();
    }
#undef HG_LOAD
}

DI void scan_mlstm(const ScanArgs& A, LAS unsigned char* lds, int unit) {
    const int tid = otid(), dir = tid >> 8, ht = tid & 255, hw = ht >> 6, lane = tid & 63, fr = lane & 15, fq = lane >> 4;
    const int b = 0, h = (unit >> 1) & 3, vs = unit & 1;
    LAS unsigned char* L = lds + dir * 63488;
    LAS bf16_t* Qs = (LAS bf16_t*)L;
    LAS bf16_t* Ks = Qs + 64 * 72;
    LAS bf16_t* KhT = Ks + 64 * 72;
    LAS bf16_t* Vt = KhT + 64 * 72;
    LAS bf16_t* Sc = Vt + 80 * 72;
    LAS bf16_t* Cb = Sc + 64 * 72;
    LAS float* G2 = (LAS float*)(Cb + 80 * 72);
    LAS float* M2 = G2 + 64; LAS float* WI = M2 + 64; LAS float* EM = WI + 64; LAS float* WS = EM + 64; LAS float* MISC = WS + 64;
    for (int i = ht; i < 16 * 72; i += 256) Vt[64 * 72 + i] = (i < 72) ? (bf16_t)0x3F80u : (bf16_t)0u;
    const int t_ld = ht >> 2, cg = ht & 3;
    const bf16_t* Pq = A.P + 2048 + h * 64 + cg * 16;
    const bf16_t* Pk = A.P + 2304 + h * 64 + cg * 16;
    const bf16_t* Pv = A.P + 2560 + h * 128 + vs * 64 + cg * 16;
    u32x4 rq[2], rk[2], rv[2]; float rig = 0.f, rfg = 0.f; unsigned long long pr[4] = {0ull, 0ull, 0ull, 0ull}; int pmode = 0;
    bf16_t* const opb = A.AS + 512 + h * 128 + vs * 64 + 4 * fq;
    f32x4 C[5];
#pragma unroll
    for (int c = 0; c < 5; ++c) C[c] = (f32x4){0.f, 0.f, 0.f, 0.f};
    float m2prev = 0.f;
    int rowbase, pos0, slen; bool first, isx;
    chunk_geom(0, b, dir, rowbase, pos0, slen, first, isx);
#define ML_LOAD() do { const size_t r = (size_t)(rowbase + (dir ? 63 - t_ld : t_ld)) * NP; \
        rq[0] = *(const u32x4*)(Pq + r); rq[1] = *(const u32x4*)(Pq + r + 8); rk[0] = *(const u32x4*)(Pk + r); rk[1] = *(const u32x4*)(Pk + r + 8); rv[0] = *(const u32x4*)(Pv + r); rv[1] = *(const u32x4*)(Pv + r + 8); \
        if (hw == 0) { const float* g = A.MLG + (size_t)(rowbase + (dir ? 63 - lane : lane)) * 16 + dir * 4 + h; rig = g[0]; rfg = g[8]; } \
        if (pmode == 1 && !late_pre(jnx)) { const int t = 16 * hw + fr; const bf16_t* op = opb + (size_t)(rowbase + (dir ? 63 - t : t)) * 1024; _Pragma("unroll") for (int c = 0; c < 4; ++c) pr[c] = ld8_coh(op + 16 * c); } } while (0)
    int jnx = 0;
    pmode = (A.last && !isx) ? 0 : pre_mode(first, 0);
    ML_LOAD();
    for (int j = 0; j < NSTEP; ++j) {
        const int orow = rowbase; const bool owrite = !(A.last && !isx); const int omode = pmode;
        if (late_pre(j) && pmode == 1) { const int t = 16 * hw + fr; const bf16_t* op = opb + (size_t)(rowbase + (dir ? 63 - t : t)) * 1024; _Pragma("unroll") for (int c = 0; c < 4; ++c) pr[c] = ld8_coh(op + 16 * c); }
        unsigned long long opr[4] = {pr[0], pr[1], pr[2], pr[3]};
        asm volatile("" : "+v"(opr[0]), "+v"(opr[1]), "+v"(opr[2]), "+v"(opr[3]));
#pragma unroll
        for (int c = 0; c < 5; ++c) { u32x2 w; w.x = pk2(C[c][0], C[c][1]); w.y = pk2(C[c][2], C[c][3]); *(LAS u32x2*)(Cb + (16 * c + fr) * 72 + 16 * hw + 4 * fq) = w; }
        *(LAS u32x4*)(Qs + t_ld * 72 + cg * 16) = rq[0]; *(LAS u32x4*)(Qs + t_ld * 72 + cg * 16 + 8) = rq[1];
        *(LAS u32x4*)(Ks + t_ld * 72 + cg * 16) = rk[0]; *(LAS u32x4*)(Ks + t_ld * 72 + cg * 16 + 8) = rk[1];
        { const unsigned vw[8] = {rv[0].x, rv[0].y, rv[0].z, rv[0].w, rv[1].x, rv[1].y, rv[1].z, rv[1].w};
#pragma unroll
            for (int e = 0; e < 8; ++e) { Vt[(cg * 16 + 2 * e) * 72 + t_ld] = (bf16_t)(vw[e] & 0xffffu); Vt[(cg * 16 + 2 * e + 1) * 72 + t_ld] = (bf16_t)(vw[e] >> 16); } }
        if (hw == 0) {
            const float i2 = rig * LOG2E, lf2 = -lg2(1.f + ex2(-rfg * LOG2E));
            float b2 = lf2;
#pragma unroll
            for (int o = 1; o < 64; o <<= 1) { const float y = __shfl_up(b2, o); if (lane >= o) b2 += y; }
            const float g2 = i2 - b2; float pm = g2;
#pragma unroll
            for (int o = 1; o < 64; o <<= 1) { const float y = __shfl_up(pm, o); if (lane >= o) pm = fmaxf(pm, y); }
            const float m2 = fmaxf(pm, m2prev);
            const float m63 = __shfl(m2, 63), b63 = __shfl(b2, 63);
            G2[lane] = g2; M2[lane] = m2; WI[lane] = ex2(m2prev - m2); EM[lane] = ex2(fminf(-(b2 + m2), ECLAMP)); WS[lane] = ex2(g2 - m63);
            if (lane == 0) MISC[0] = ex2(m2prev - m63);
            m2prev = b63 + m63;
        }
        LBAR();
        { const float ws = WS[t_ld]; const unsigned kw[8] = {rk[0].x, rk[0].y, rk[0].z, rk[0].w, rk[1].x, rk[1].y, rk[1].z, rk[1].w};
#pragma unroll
            for (int e = 0; e < 8; ++e) { const unsigned p = pk2(bflo(kw[e]) * ws, bfhi(kw[e]) * ws); KhT[(cg * 16 + 2 * e) * 72 + t_ld] = (bf16_t)(p & 0xffffu); KhT[(cg * 16 + 2 * e + 1) * 72 + t_ld] = (bf16_t)(p >> 16); } }
        LBAR();
        if (j + 1 < NSTEP) { chunk_geom(j + 1, b, dir, rowbase, pos0, slen, first, isx); pmode = (A.last && !isx) ? 0 : pre_mode(first, j + 1); jnx = j + 1; ML_LOAD(); }
        const int t = 16 * hw + fr; const float mt = M2[t];
#pragma unroll
        for (int st = 0; st < 4; ++st) {
            f32x4 acc = (f32x4){0.f, 0.f, 0.f, 0.f};
            if (st <= hw) {
#pragma unroll
                for (int kk = 0; kk < 2; ++kk) acc = mfma16(ldfrag(Ks, 72, 16 * st, 32 * kk, lane), ldfrag(Qs, 72, 16 * hw, 32 * kk, lane), acc);
#pragma unroll
                for (int i = 0; i < 4; ++i) { const float wgt = ex2(G2[16 * st + 4 * fq + i] - mt); acc[i] = (st < hw || 4 * fq + i <= fr) ? acc[i] * wgt : 0.f; }
            }
            u32x2 w; w.x = pk2(acc[0], acc[1]); w.y = pk2(acc[2], acc[3]);
            *(LAS u32x2*)(Sc + (16 * hw + fr) * 72 + 16 * st + 4 * fq) = w;
        }
        {
            f32x4 nu[5]; const float wi = WI[t];
#pragma unroll
            for (int c = 0; c < 5; ++c) { f32x4 a1 = (f32x4){0.f, 0.f, 0.f, 0.f}, a2 = (f32x4){0.f, 0.f, 0.f, 0.f};
#pragma unroll
                for (int ks = 0; ks < 2; ++ks) a1 = mfma16(ldfrag(Vt, 72, 16 * c, 32 * ks, lane), ldfrag(Sc, 72, 16 * hw, 32 * ks, lane), a1);
#pragma unroll
                for (int kk = 0; kk < 2; ++kk) a2 = mfma16(ldfrag(Cb, 72, 16 * c, 32 * kk, lane), ldfrag(Qs, 72, 16 * hw, 32 * kk, lane), a2);
                nu[c] = a1 + a2 * wi; }
            const float den = __shfl(nu[4][0], fr);
            const float inv = rcpf_(fmaxf(fabsf(den), EM[t]));
            bf16_t* op = opb + (size_t)(orow + (dir ? 63 - t : t)) * 1024;
            if (owrite) {
#pragma unroll
                for (int c = 0; c < 4; ++c) out_put4(op + 16 * c, nu[c] * inv, omode, opr[c]); }
        }
        { const float carry = MISC[0];
#pragma unroll
            for (int c = 0; c < 5; ++c) { f32x4 d = C[c] * carry;
#pragma unroll
                for (int ks = 0; ks < 2; ++ks) d = mfma16(ldfrag(KhT, 72, 16 * hw, 32 * ks, lane), ldfrag(Vt, 72, 16 * c, 32 * ks, lane), d);
                C[c] = d; } }
        if (j == 1 || j == 35) asm volatile("s_waitcnt vmcnt(0)" ::: "memory");
        LBAR();
    }
#undef ML_LOAD
}

DI void scan_lru(const ScanArgs& A, LAS unsigned char* lds, int unit) {
    const int tid = otid(), dir = tid >> 8, ht = tid & 255, hw = ht >> 6, lane = tid & 63, fr = lane & 15, fq = lane >> 4;
    const int b = 0, nbk = unit & 7;
    LAS unsigned char* L = lds + dir * 76288;
    LAS bf16_t* WG = (LAS bf16_t*)L;
    LAS bf16_t* XC = WG + 2 * 64 * 72;
    LAS bf16_t* XR = XC + 64 * 72;
    LAS float* AA = (LAS float*)(XR + 68 * 64);
    LAS float* UU = AA + 64 * 68;
    LAS float* CW = UU + 64 * 68;
    LAS float* CB = CW + 256; LAS float* BRr = CB + 64; LAS float* BIi = BRr + 64; LAS float* C8 = BIi + 64; LAS float* SEGA = C8 + 64; LAS float* SEGH = SEGA + 256; LAS float* HST = SEGH + 256;
    for (int i = ht; i < 2 * 64 * 64; i += 256) { const int g = i >> 12, d = (i >> 6) & 63, e = i & 63;
        WG[(g * 64 + e) * 72 + d] = (bf16_t)(pk2(A.gw[(((size_t)(dir * 2 + g) * 8 + nbk) * 64 + d) * 64 + e], 0.f) & 0xffffu); }
    for (int i = ht; i < 256; i += 256) CW[i] = A.convw[(i >> 6) * 512 + nbk * 64 + (i & 63)];
    if (ht < 128) HST[ht] = 0.f;
    if (ht < 64) { CB[ht] = A.convb[nbk * 64 + ht]; BRr[ht] = A.gb[(dir * 2 + 0) * 512 + nbk * 64 + ht]; BIi[ht] = A.gb[(dir * 2 + 1) * 512 + nbk * 64 + ht];
        const float lm = A.lam[dir * 512 + nbk * 64 + ht]; const float sp = (lm > 15.f) ? __expf(-lm) : log1pf(__expf(-lm)); C8[ht] = -8.f * sp * LOG2E; }
    const bf16_t* Px = A.P + 3072 + nbk * 64;
    u32x4 rx[3]; unsigned long long pr[4] = {0ull, 0ull, 0ull, 0ull}; int pmode = 0;
    bf16_t* const opb = A.SL + nbk * 64 + (ht & 3) * 16;
    int rowbase, pos0, slen; bool first, isx;
    chunk_geom(0, b, dir, rowbase, pos0, slen, first, isx);
#define LRU_LOAD() do { _Pragma("unroll") for (int q = 0; q < 3; ++q) { const int id = ht + 256 * q, i = id >> 3, c8 = id & 7; const int pos = pos0 - 2 + i; \
        rx[q] = (u32x4){0u, 0u, 0u, 0u}; if (id < 544 && pos >= 0 && pos < slen) rx[q] = *(const u32x4*)(Px + (size_t)(rowbase - 2 + i) * NP + c8 * 8); } \
        if (pmode == 1 && !late_pre(jnx)) { const int t = ht >> 2; const bf16_t* op = opb + (size_t)(rowbase + (dir ? 63 - t : t)) * 512; _Pragma("unroll") for (int q = 0; q < 4; ++q) pr[q] = ld8_coh(op + 4 * q); } } while (0)
    int jnx = 0;
    pmode = (A.last && !isx) ? 0 : pre_mode(first, 0);
    LRU_LOAD();
    LBAR();
    for (int j = 0; j < NSTEP; ++j) {
        const int orow = rowbase; const bool owrite = !(A.last && !isx); const int omode = pmode;
        if (late_pre(j) && pmode == 1) { const int t = ht >> 2; const bf16_t* op = opb + (size_t)(rowbase + (dir ? 63 - t : t)) * 512; _Pragma("unroll") for (int q = 0; q < 4; ++q) pr[q] = ld8_coh(op + 4 * q); }
        unsigned long long opr[4] = {pr[0], pr[1], pr[2], pr[3]};
        asm volatile("" : "+v"(opr[0]), "+v"(opr[1]), "+v"(opr[2]), "+v"(opr[3]));
#pragma unroll
        for (int q = 0; q < 3; ++q) { const int id = ht + 256 * q; if (id < 544) *(LAS u32x4*)(XR + (id >> 3) * 64 + (id & 7) * 8) = rx[q]; }
        LBAR();
        if (j + 1 < NSTEP) { chunk_geom(j + 1, b, dir, rowbase, pos0, slen, first, isx); pmode = (A.last && !isx) ? 0 : pre_mode(first, j + 1); jnx = j + 1; LRU_LOAD(); }
        { const int t = ht >> 2, d0 = (ht & 3) * 16, i0 = dir ? 63 - t : t; float xc[16];
#pragma unroll
            for (int e4 = 0; e4 < 4; ++e4) { const f32x4 c4 = *(const LAS f32x4*)(CB + d0 + 4 * e4); xc[4 * e4] = c4[0]; xc[4 * e4 + 1] = c4[1]; xc[4 * e4 + 2] = c4[2]; xc[4 * e4 + 3] = c4[3]; }
#pragma unroll
            for (int tap = 0; tap < 4; ++tap) { const u32x4 a0 = *(const LAS u32x4*)(XR + (i0 + tap) * 64 + d0), a1 = *(const LAS u32x4*)(XR + (i0 + tap) * 64 + d0 + 8);
                const unsigned ww[8] = {a0.x, a0.y, a0.z, a0.w, a1.x, a1.y, a1.z, a1.w};
#pragma unroll
                for (int e4 = 0; e4 < 4; ++e4) { const f32x4 w4 = *(const LAS f32x4*)(CW + tap * 64 + d0 + 4 * e4);
                    xc[4 * e4] += w4[0] * bflo(ww[2 * e4]); xc[4 * e4 + 1] += w4[1] * bfhi(ww[2 * e4]); xc[4 * e4 + 2] += w4[2] * bflo(ww[2 * e4 + 1]); xc[4 * e4 + 3] += w4[3] * bfhi(ww[2 * e4 + 1]); } }
            u32x4 w0, w1; w0.x = pk2(xc[0], xc[1]); w0.y = pk2(xc[2], xc[3]); w0.z = pk2(xc[4], xc[5]); w0.w = pk2(xc[6], xc[7]); w1.x = pk2(xc[8], xc[9]); w1.y = pk2(xc[10], xc[11]); w1.z = pk2(xc[12], xc[13]); w1.w = pk2(xc[14], xc[15]);
            *(LAS u32x4*)(XC + t * 72 + d0) = w0; *(LAS u32x4*)(XC + t * 72 + d0 + 8) = w1; }
        LBAR();
        { const int t = 16 * hw + fr;
#pragma unroll
            for (int et = 0; et < 4; ++et) { f32x4 ar = (f32x4){0.f, 0.f, 0.f, 0.f}, ai = (f32x4){0.f, 0.f, 0.f, 0.f};
#pragma unroll
                for (int kk = 0; kk < 2; ++kk) { const bf16x8 xb = ldfrag(XC, 72, 16 * hw, 32 * kk, lane);
                    ar = mfma16(ldfrag(WG, 72, 16 * et, 32 * kk, lane), xb, ar); ai = mfma16(ldfrag(WG + 64 * 72, 72, 16 * et, 32 * kk, lane), xb, ai); }
                const int e0 = 16 * et + 4 * fq; f32x4 av, uv;
                const u32x2 xw = *(const LAS u32x2*)(XC + t * 72 + e0); const float xv[4] = {bflo(xw.x), bfhi(xw.x), bflo(xw.y), bfhi(xw.y)};
                const f32x4 br4 = *(const LAS f32x4*)(BRr + e0), bi4 = *(const LAS f32x4*)(BIi + e0), c84 = *(const LAS f32x4*)(C8 + e0);
#pragma unroll
                for (int i = 0; i < 4; ++i) { const float r = ar[i] + br4[i], g = ai[i] + bi4[i];
                    const float pa = 1.f + ex2(-LOG2E * r), pb = 1.f + ex2(-LOG2E * g);
                    const float pm = fminf(pa * pb, 3.0e38f), rinv = rcpf_(pm);
                    const float sr = fminf(pb, 3.0e38f) * rinv, sg = fminf(pa, 3.0e38f) * rinv;
                    const float al = ex2(c84[i] * sr);
                    av[i] = al; uv[i] = __builtin_amdgcn_sqrtf(fmaxf(1.f - al * al, 0.f)) * sg * xv[i]; }
                *(LAS f32x4*)(AA + t * 68 + e0) = av; *(LAS f32x4*)(UU + t * 68 + e0) = uv; } }
        LBAR();
        {
            float hv[16], av[16]; float ap = 1.f, hl = 0.f;
#pragma unroll
            for (int i = 0; i < 16; ++i) { const float al = AA[(16 * hw + i) * 68 + lane], uu = UU[(16 * hw + i) * 68 + lane]; hl = al * hl + uu; ap *= al; hv[i] = hl; av[i] = ap; }
            SEGA[hw * 64 + lane] = ap; SEGH[hw * 64 + lane] = hl;
            LBAR();
            float carry = HST[(j & 1) * 64 + lane];
            for (int sg = 0; sg < hw; ++sg) carry = SEGA[sg * 64 + lane] * carry + SEGH[sg * 64 + lane];
#pragma unroll
            for (int i = 0; i < 16; ++i) UU[(16 * hw + i) * 68 + lane] = hv[i] + av[i] * carry;
            if (hw == 3) HST[((j + 1) & 1) * 64 + lane] = hv[15] + av[15] * carry;
        }
        LBAR();
        if (owrite) { const int t = ht >> 2, d0 = (ht & 3) * 16; bf16_t* op = opb + (size_t)(orow + (dir ? 63 - t : t)) * 512;
#pragma unroll
            for (int q = 0; q < 4; ++q) out_put4(op + 4 * q, *(const LAS f32x4*)(UU + t * 68 + d0 + 4 * q), omode, opr[q]); }
        if (j == 1 || j == 35) asm volatile("s_waitcnt vmcnt(0)" ::: "memory");
    }
    LBAR();
#undef LRU_LOAD
}
DI void phase_scan(const ScanArgs& A, LAS unsigned char* lds, int gr, int gs) {
    for (int u = gr; u < 32; u += gs) {
#ifndef NO_HG
        if (u < 16) scan_hgrn2(A, lds, u);
#ifdef DBL_HG
        if (u < 16) { __syncthreads(); scan_hgrn2(A, lds, u); }
#endif
#endif
#ifndef NO_ML
        if (u >= 16 && u < 24) scan_mlstm(A, lds, u - 16);
#ifdef DBL_ML
        if (u >= 16 && u < 24) { __syncthreads(); scan_mlstm(A, lds, u - 16); }
#endif
#endif
#ifndef NO_LRU
        if (u >= 24) scan_lru(A, lds, u - 24);
#ifdef DBL_LRU
        if (u >= 24) { __syncthreads(); scan_lru(A, lds, u - 24); }
#endif
#endif
        __syncthreads();
    }
}


#ifdef PROBE_CS
DI void cksum(const void* p, size_t bytes, unsigned long long* dst, int gr, int gs) {
    const unsigned* w = (const unsigned*)p; const size_t n = bytes / 4; unsigned long long acc = 0;
    const int tid = otid();
    for (unsigned i = (unsigned)gr * 512u + (unsigned)tid; i < (unsigned)n; i += (unsigned)gs * 512u) acc += (unsigned long long)w[i] * (unsigned long long)((i & 1023u) + 1u);
#pragma unroll
    for (int o = 1; o < 64; o <<= 1) acc += __shfl_xor(acc, o);
    if ((tid & 63) == 0) atomicAdd(dst, acc);
}
__global__ void cs_compare(const unsigned long long* CS, float* out, int n) {
    const size_t gt = (size_t)blockIdx.x * blockDim.x + threadIdx.x, gs = (size_t)gridDim.x * blockDim.x;
    int code = 0;
    for (int p = 63; p >= 0; --p) if (CS[p] != CS[64 + p]) code = p + 1;
    for (size_t i = gt; i < (size_t)n; i += gs) out[i] = (i == 0) ? 1000.f * (float)code : 0.f;
}
#define CK(idx, ptr, bytes) do { if (l == PROBE_CS - 1) cksum(ptr, bytes, CSA + a.run * 64 + (idx), gr, gs); } while (0)
#else
#define CK(idx, ptr, bytes) do { } while (0)
#endif
DI unsigned xcc_id() { return (unsigned)__builtin_amdgcn_s_getreg((3 << 11) | 20) & 0xFu; }
DI void xsync(unsigned* bar, unsigned gs, unsigned& epoch) {
    asm volatile("s_waitcnt vmcnt(0) lgkmcnt(0)" ::: "memory");
    __syncthreads();
    epoch = __builtin_amdgcn_readfirstlane(epoch + 1u);
    if (threadIdx.x == 0) {
        const unsigned old = __hip_atomic_fetch_add(bar, 1u, __ATOMIC_RELAXED, __HIP_MEMORY_SCOPE_AGENT);
        if (old + 1u == epoch * gs) __hip_atomic_store(bar + 64, epoch, __ATOMIC_RELAXED, __HIP_MEMORY_SCOPE_AGENT);
        else while (__hip_atomic_load(bar + 64, __ATOMIC_RELAXED, __HIP_MEMORY_SCOPE_AGENT) < epoch) __builtin_amdgcn_s_sleep(1);
    }
    if (threadIdx.x < 64) {
        __builtin_amdgcn_fence(__ATOMIC_ACQUIRE, "agent");
        asm volatile("s_waitcnt vmcnt(0)" ::: "memory");
    }
    __syncthreads();
}
__global__ void __launch_bounds__(512, 2) fwd_kernel(KArgs a) {
    extern __shared__ __attribute__((aligned(16))) unsigned char lds_raw[];
    LAS unsigned char* lds = (LAS unsigned char*)lds_raw;
    cg::grid_group grid = cg::this_grid();
#define GSYNC() do { asm volatile("s_waitcnt vmcnt(0) lgkmcnt(0)" ::: "memory"); grid.sync(); if (threadIdx.x < 64) { __builtin_amdgcn_fence(__ATOMIC_ACQUIRE, "agent"); asm volatile("s_waitcnt vmcnt(0)" ::: "memory"); } __syncthreads(); } while (0)
    unsigned char* ws = a.ws;
    float* MOD = (float*)(ws + WS_MOD); float* BIASA = (float*)(ws + WS_BIAS); float* LB = (float*)(ws + WS_LB); float* MLG = (float*)(ws + WS_MLG);
    unsigned* CTL = (unsigned*)(ws + WS_CTL);
    unsigned char* wsw = ws + WS_W; float* CTXW = (float*)(ws + WS_CTXW);
    bf16_t* AS = (bf16_t*)(ws + WS_AS); bf16_t* SL = (bf16_t*)(ws + WS_SL); bf16_t* BR = (bf16_t*)(ws + WS_BR); bf16_t* P = (bf16_t*)(ws + WS_P);

    volatile LAS unsigned* GI = (volatile LAS unsigned*)(lds + LDS_BYTES - 64);
    const unsigned myx = xcc_id();
    if (threadIdx.x == 0) GI[0] = __hip_atomic_fetch_add(CTL + 64 * myx + a.run * 8192, 1u, __ATOMIC_RELAXED, __HIP_MEMORY_SCOPE_AGENT);
    phase_mod(a, lds, MOD, LB);
    phase_conv(a, lds, 0, wsw, BIASA);
    GSYNC();
    if (threadIdx.x == 0) { unsigned ng = 0, g = 0, gs = 1;
        for (unsigned x = 0; x < 16; ++x) { const unsigned c = __hip_atomic_load(CTL + 64 * x + a.run * 8192, __ATOMIC_RELAXED, __HIP_MEMORY_SCOPE_AGENT); if (c) { if (x == myx) { g = ng; gs = c; } ++ng; } }
        GI[1] = g; GI[2] = gs; GI[3] = ng; }
    __syncthreads();
    const int gr = __builtin_amdgcn_readfirstlane((int)GI[0]), gg = __builtin_amdgcn_readfirstlane((int)GI[1]), gs = __builtin_amdgcn_readfirstlane((int)GI[2]), ng = __builtin_amdgcn_readfirstlane((int)GI[3]);
    unsigned* bar = CTL + 2048 + 128 * gg + a.run * 4096; unsigned epoch = 0;
    unsigned long long* CSA = (unsigned long long*)(ws + WS_LB + 32768); (void)CSA;
#define XSYNC() xsync(bar, (unsigned)gs, epoch)
    constexpr int RB = 4352;

    for (int l = 0; l < DEPTH; ++l) {
        const bool last = (l == DEPTH - 1); const int cm = l & 1;
        const float* xs = (l == 0) ? a.in[0] : a.out; const float* cs = (l == 0) ? a.in[2] : CTXW;
        const float* modl = MOD + (size_t)l * 9 * 6144; const float* BIAS = BIASA + l * NW1;
        const int Mall = RB, Mx = last ? 4096 : RB;
        unsigned char* wl = (l & 1) ? ws + WS_W2 : wsw;
        const bf16_t* W1 = (const bf16_t*)(wl + W_W1); const bf16_t* WGt = W1 + (size_t)N1 * 1024; const bf16_t* WBR = (const bf16_t*)(wl + W_BR);
        const bf16_t* WO = (const bf16_t*)(wl + W_O); const bf16_t* WFI = (const bf16_t*)(wl + W_FI); const bf16_t* WFO = (const bf16_t*)(wl + W_FO);
        for (int b = gg; b < NB; b += ng) phase_norm(xs, cs, a.in[6] + l * 1024, modl, 0, 1, cm, AS + (size_t)b * RB * 1024, Mall, b, gr, gs);
        if (l > 0) GSYNC(); else XSYNC();
        for (int b = gg; b < NB; b += ng) { CK(3, AS + (size_t)b * RB * 1024, (size_t)RB * 2048); }
        for (int b = gg; b < NB; b += ng) { Epi1 E{P + (size_t)b * RB * NP, BR + (size_t)b * RB * 1536, MLG + (size_t)b * RB * 16, BIAS, LB + l * 1024}; run_gemm(lds, AS + (size_t)b * RB * 1024, W1, Mall, N1, 1024, E, gr, gs); }
        XSYNC();
        for (int b = gg; b < NB; b += ng) { CK(4, P + (size_t)b * RB * NP, (size_t)RB * NP * 2); CK(5, BR + (size_t)b * RB * 1536, (size_t)RB * 1024); CK(6, MLG + (size_t)b * RB * 16, (size_t)RB * 64); }
        for (int b = gg; b < NB; b += ng) { ScanArgs S{P + (size_t)b * RB * NP, MLG + (size_t)b * RB * 16, AS + (size_t)b * RB * 1024, SL + (size_t)b * RB * 512, a.in[12] + l * 4 * 512, a.in[13] + l * 512, a.in[14] + (size_t)l * 2 * 2 * 8 * 64 * 64, a.in[15] + l * 2 * 2 * 512, a.in[16] + l * 2 * 512, last ? 1 : 0};
            phase_scan(S, lds, gr, gs);
#ifdef DBL_SCAN
            phase_scan(S, lds, gr, gs);
#endif
            }
        XSYNC();
        for (int b = gg; b < NB; b += ng) { CK(7, AS + (size_t)b * RB * 1024, (size_t)RB * 2048); CK(8, SL + (size_t)b * RB * 512, (size_t)RB * 1024); }
        for (int b = gg; b < NB; b += ng) phase_fin(xs, cs, a.in[6] + l * 1024, modl, cm, AS + (size_t)b * RB * 1024, SL + (size_t)b * RB * 512, BR + (size_t)b * RB * 1536, a.in[10] + l * 512, a.in[11] + l * 512, Mx, b, gr, gs);
        XSYNC();
        for (int b = gg; b < NB; b += ng) { CK(9, AS + (size_t)b * RB * 1024, (size_t)RB * 2048); CK(10, BR + (size_t)b * RB * 1536, (size_t)RB * 1024); }
        for (int b = gg; b < NB; b += ng) { Epi2 E{P + (size_t)b * RB * NP, BIAS + N1}; run_gemm(lds, AS + (size_t)b * RB * 1024, WGt, Mx, NG, 1024, E, gr, gs); }
        XSYNC();
        for (int b = gg; b < NB; b += ng) { CK(11, P + (size_t)b * RB * NP, (size_t)RB * NG * 2); }
        for (int b = gg; b < NB; b += ng) { Epi3 E{P + (size_t)b * RB * NP, AS + (size_t)b * RB * 1024}; run_gemm(lds, BR + (size_t)b * RB * 1536, WBR, Mx, 1024, 1536, E, gr, gs); }
        XSYNC();
        for (int b = gg; b < NB; b += ng) { CK(12, AS + (size_t)b * RB * 1024, (size_t)RB * 2048); }
        for (int b = gg; b < NB; b += ng) { EpiRes E{xs, a.out, cs, CTXW, modl + 2 * 1024, cm, ((PROBE_MIX >> l) & 1) ? 0.f : 1.f, b}; run_gemm(lds, AS + (size_t)b * RB * 1024, WO, Mx, 1024, 1024, E, gr, gs); }
        XSYNC();
        for (int b = gg; b < NB; b += ng) { CK(13, a.out + (size_t)b * 4096 * 1024, (size_t)4096 * 4096); CK(14, CTXW + (size_t)b * 256 * 1024, (size_t)256 * 4096); }
        for (int b = gg; b < NB; b += ng) phase_norm(a.out, CTXW, a.in[19] + l * 1024, modl, 3, 4, 0, AS + (size_t)b * RB * 1024, Mx, b, gr, gs);
#ifdef DBL_P5
        for (int b = gg; b < NB; b += ng) phase_norm(a.out, CTXW, a.in[19] + l * 1024, modl, 3, 4, 0, AS + (size_t)b * RB * 1024, Mx, b, gr, gs);
#endif
        XSYNC();
        for (int b = gg; b < NB; b += ng) { CK(15, AS + (size_t)b * RB * 1024, (size_t)RB * 2048); }
        for (int b = gg; b < NB; b += ng) { Epi5 E{P + (size_t)b * RB * NP}; run_gemm(lds, AS + (size_t)b * RB * 1024, WFI, Mx, 2 * FF, 1024, E, gr, gs); }
#ifdef DBL_G5
        for (int b = gg; b < NB; b += ng) { Epi5 E{P + (size_t)b * RB * NP}; run_gemm(lds, AS + (size_t)b * RB * 1024, WFI, Mx, 2 * FF, 1024, E, gr, gs); }
#endif
        XSYNC();
        for (int b = gg; b < NB; b += ng) { CK(16, P + (size_t)b * RB * NP, (size_t)RB * FF * 2); }
        for (int b = gg; b < NB; b += ng) { EpiRes E{a.out, a.out, CTXW, CTXW, modl + 5 * 1024, 0, ((PROBE_FFN >> l) & 1) ? 0.f : 1.f, b}; run_gemm(lds, P + (size_t)b * RB * NP, WFO, Mx, 1024, FF, E, gr, gs); }
        if (!last) phase_conv_q(a, lds, l + 1, ((l + 1) & 1) ? ws + WS_W2 : wsw, BIASA, CTL + 12288 + 64 * l);
        XSYNC();
        for (int b = gg; b < NB; b += ng) { CK(17, a.out + (size_t)b * 4096 * 1024, (size_t)4096 * 4096); }
    }
    for (int b = gg; b < NB; b += ng) phase_final(a.out + (size_t)b * 4096 * 1024, a.in[22], gr, gs);
}

extern "C" void kernel_launch(void* const* d_in, const int* in_sizes, int n_in, void* d_out, int out_size, void* d_ws, size_t ws_size, hipStream_t stream) {
    static int grid = 0;
    if (grid == 0) {
        if (n_in != 23 || out_size != MX * D || ws_size < WS_END) { fprintf(stderr, "kernel_launch: unexpected problem (n_in %d out %d ws %zu need %zu)\n", n_in, out_size, ws_size, (size_t)WS_END); grid = -1; return; }
        int dev = 0, cus = 0, per_cu = 0;
        if (hipGetDevice(&dev) != hipSuccess || hipDeviceGetAttribute(&cus, hipDeviceAttributeMultiprocessorCount, dev) != hipSuccess) { grid = -1; return; }
        if (hipFuncSetAttribute((const void*)fwd_kernel, hipFuncAttributeMaxDynamicSharedMemorySize, LDS_BYTES) != hipSuccess) { fprintf(stderr, "kernel_launch: hipFuncSetAttribute failed\n"); grid = -1; return; }
        if (hipOccupancyMaxActiveBlocksPerMultiprocessor(&per_cu, (const void*)fwd_kernel, 512, LDS_BYTES) != hipSuccess || per_cu < 1) { fprintf(stderr, "kernel_launch: occupancy query says %d\n", per_cu); per_cu = 1; }
        (void)hipGetLastError();
        grid = cus * per_cu;
        if (grid > 256) grid = 256;
    }
    if (grid < 0) return;
    (void)hipMemsetAsync((char*)d_ws + WS_CTL, 0, 65536, stream);
    KArgs a{};
    for (int i = 0; i < 23; ++i) a.in[i] = (const float*)d_in[i];
    a.out = (float*)d_out; a.ws = (unsigned char*)d_ws;
    void* args[] = {&a};
#ifdef PROBE_CS
    (void)hipMemsetAsync((char*)d_ws + WS_LB + 32768, 0, 1024, stream);
    (void)hipLaunchCooperativeKernel((void*)fwd_kernel, dim3(grid), dim3(512), args, LDS_BYTES, stream);
    a.run = 1;
#endif
    hipError_t e = hipLaunchCooperativeKernel((void*)fwd_kernel, dim3(grid), dim3(512), args, LDS_BYTES, stream);
#ifdef PROBE_CS
    hipLaunchKernelGGL(cs_compare, dim3(1024), dim3(256), 0, stream, (const unsigned long long*)((char*)d_ws + WS_LB + 32768), (float*)d_out, out_size);
#endif
    if (e != hipSuccess) fprintf(stderr, "kernel_launch: cooperative launch failed: %s (grid %d)\n", hipGetErrorString(e), grid);
}
```

```cpp
#include <hip/hip_runtime.h>
#include <hip/hip_cooperative_groups.h>
#include <cstdio>
#include <cstdint>
namespace cg = cooperative_groups;
#ifndef PROBE_MIX
#define PROBE_MIX 0
#endif
#ifndef PROBE_FFN
#define PROBE_FFN 0
#endif
#ifndef PROBE_BR
#define PROBE_BR 0
#endif
#define PG8_ALIGN_V true
#define PG8_SP2_V true
namespace pg8 {
#define PG8_LAS __attribute__((address_space(3)))
typedef unsigned short bf16_t;
typedef short bf16x8 __attribute__((ext_vector_type(8)));
typedef float f32x4 __attribute__((ext_vector_type(4)));
typedef unsigned u32x4 __attribute__((ext_vector_type(4)));
constexpr int BM = 256, BK = 64, HALF = 128, HTB = HALF * BK * 2  , STAGE_BYTES = 8 * HTB, NXCD = 8, WGM = 8;

__host__ __device__ __forceinline__ int lds_byte(int r, int c) { const int st = (r >> 4) * 2 + (c >> 5), rr = r & 15, cc = c & 31, ob = rr * 64 + cc * 2; return st * 1024 + (ob ^ (((ob >> 9) & 1) << 5)); }
__host__ __device__ __forceinline__ void stage_rc(int b, int& R, int& C) { const int st = b / 1024, sb = b % 1024, swz = sb ^ (((sb >> 9) & 1) << 5); R = (st >> 1) * 16 + swz / 64; C = (st & 1) * 32 + (swz % 64) / 2; }
__host__ __device__ __forceinline__ int perm32(int rho) { const int n = rho >> 4, i = rho & 15; return 8 * (i >> 2) + 4 * n + (i & 3); }

struct Unit { int pm, pn; };
struct Gemm { const bf16_t* A; const bf16_t* Bt; int M, N, K; };

struct StaticOrder {
    int nM, nN, nwg, G, c;
    __host__ __device__ void init(int M, int N, int G_, int c_) { nM = M / BM; nN = N / BM; nwg = nM * nN; G = G_; c = c_; }
    __host__ __device__ bool next(int i, Unit& u) const {
        const long L = (long)i * G + c; if (L >= nwg) return false;
        int wgid = (int)L; { const int q = nwg / NXCD, r = nwg % NXCD, xcd = wgid % NXCD, off = wgid / NXCD; wgid = (xcd < r ? xcd * (q + 1) : r * (q + 1) + (xcd - r) * q) + off; }
        const int nig = WGM * nN, gid = wgid / nig, fm = gid * WGM, gsz = (nM - fm) < WGM ? (nM - fm) : WGM;
        u.pm = fm + ((wgid % nig) % gsz); u.pn = (wgid % nig) / gsz; return true;
    }
    __device__ __forceinline__ void a_ready(const Unit&) const {}
    __device__ __forceinline__ void done(const Unit&) const {}
};
__device__ __forceinline__ unsigned cvt_pk_bf16(float lo, float hi) { unsigned r; asm volatile("v_cvt_pk_bf16_f32 %0, %1, %2" : "=v"(r) : "v"(lo), "v"(hi)); return r; }
typedef float f32x2 __attribute__((ext_vector_type(2)));
template <class Epi, class Sched, bool ALIGN_EPI = false, bool SP2 = false>
__device__ __forceinline__ void gemm_phase(PG8_LAS unsigned char* lds, const Gemm g, const Sched& S, const Epi& E) {
    int tid_ = threadIdx.x; asm volatile("" : "+v"(tid_)); const int tid = tid_, wid = __builtin_amdgcn_readfirstlane(tid >> 6), lane = tid & 63, wr = wid >> 2, wc = wid & 3, fr = lane & 15, fq = lane >> 4;
    const int K = g.K, nt = K / BK;
    unsigned voffA[2], voffB[2];
#pragma unroll
    for (int i = 0; i < 2; ++i) { int R, C; stage_rc(tid * 16 + i * 8192, R, C); const int Rb = Epi::PERM ? ((R & ~31) + perm32(R & 31)) : R;
        voffA[i] = (unsigned)(R * K + C) * 2u; voffB[i] = (unsigned)(Rb * K + C) * 2u; }
    const size_t kstep = (size_t)(BK * 2);
    const size_t hstep = (size_t)HALF * K * 2;
    const size_t tstep = 2 * hstep;
    const unsigned ldsw = (unsigned)wid * 1024u;
    const int aoff = lds_byte(wr * 64 + fr, fq * 8), boff = lds_byte(wc * 32 + fr, fq * 8);
#define PG8_SA(b, h) (((b) * 2 + (h)) * HTB)
#define PG8_SB(b, h) ((4 + (b) * 2 + (h)) * HTB)
#define PG8_STAGE(bufoff, gbase, voff) do { _Pragma("unroll") for (int _i = 0; _i < 2; ++_i) \
        __builtin_amdgcn_global_load_lds((const unsigned*)((const char*)(gbase) + (voff)[_i]), (PG8_LAS unsigned*)(lds + (bufoff) + ldsw + _i * 8192), 16, 0, 0); } while (0)
#define PG8_LDA(dst, b, h) do { _Pragma("unroll") for (int m = 0; m < 4; ++m) _Pragma("unroll") for (int k = 0; k < 2; ++k) dst[m][k] = *(const PG8_LAS bf16x8*)(lds + PG8_SA(b, h) + aoff + m * 2048 + k * 1024); } while (0)
#define PG8_LDB(dst, b, h) do { _Pragma("unroll") for (int n = 0; n < 2; ++n) _Pragma("unroll") for (int k = 0; k < 2; ++k) dst[n][k] = *(const PG8_LAS bf16x8*)(lds + PG8_SB(b, h) + boff + n * 2048 + k * 1024); } while (0)
#define PG8_MMA(ai, bj, At, Bt) do { __builtin_amdgcn_s_setprio(1); _Pragma("unroll") for (int m = 0; m < 4; ++m) _Pragma("unroll") for (int n = 0; n < 2; ++n) _Pragma("unroll") for (int k = 0; k < 2; ++k) \
        acc[ai][bj][m][n] = __builtin_amdgcn_mfma_f32_16x16x32_bf16(Bt[n][k], At[m][k], acc[ai][bj][m][n], 0, 0, 0); __builtin_amdgcn_s_setprio(0); } while (0)
#define PG8_WAIT_V(n) asm volatile("s_waitcnt vmcnt(" #n ")" ::: "memory")
#define PG8_WAIT_L(n) asm volatile("s_waitcnt lgkmcnt(" #n ")" ::: "memory")
#define PG8_BAR __builtin_amdgcn_s_barrier()
#define PG8_SCHED __builtin_amdgcn_sched_barrier(0)
    Unit cur, nxt; int ui = 0;
    if (!S.next(0, cur)) return;
    f32x4 acc[2][2][4][2];
#pragma unroll
    for (int a = 0; a < 2; ++a)
#pragma unroll
        for (int b = 0; b < 2; ++b)
#pragma unroll
            for (int m = 0; m < 4; ++m)
#pragma unroll
                for (int n = 0; n < 2; ++n) acc[a][b][m][n] = (f32x4){0.f, 0.f, 0.f, 0.f};
    bf16x8 At[4][2], B0[2][2], B1[2][2];
    const char* cA = (const char*)g.A + (size_t)cur.pm * tstep; const char* cB = (const char*)g.Bt + (size_t)cur.pn * tstep;
    S.a_ready(cur);
    if constexpr (SP2) {
        PG8_STAGE(PG8_SB(0, 0), cB, voffB); PG8_STAGE(PG8_SB(0, 1), cB + hstep, voffB); PG8_STAGE(PG8_SA(0, 0), cA, voffA); PG8_STAGE(PG8_SA(0, 1), cA + hstep, voffA);
        if (wr == 1) PG8_BAR;
        PG8_WAIT_V(2); PG8_BAR;
        PG8_STAGE(PG8_SB(1, 0), cB + kstep, voffB); PG8_STAGE(PG8_SA(1, 0), cA + kstep, voffA); PG8_STAGE(PG8_SB(1, 1), cB + hstep + kstep, voffB);
        PG8_WAIT_V(6); PG8_BAR;
    } else {
        PG8_STAGE(PG8_SB(0, 0), cB, voffB); PG8_STAGE(PG8_SA(0, 0), cA, voffA); PG8_STAGE(PG8_SB(0, 1), cB + hstep, voffB); PG8_STAGE(PG8_SA(0, 1), cA + hstep, voffA);
        if (wr == 1) PG8_BAR;
        PG8_WAIT_V(4); PG8_BAR;
        PG8_STAGE(PG8_SB(1, 0), cB + kstep, voffB); PG8_STAGE(PG8_SA(1, 0), cA + kstep, voffA); PG8_STAGE(PG8_SB(1, 1), cB + hstep + kstep, voffB);
        PG8_WAIT_V(6); PG8_BAR;
    }
    for (;;) {
        const bool has_next = S.next(ui + 1, nxt);
        const char* nA = has_next ? (const char*)g.A + (size_t)nxt.pm * tstep : cA; const char* nB = has_next ? (const char*)g.Bt + (size_t)nxt.pn * tstep : cB;
        for (int t = 0; t < nt; t += 2) {
            const bool last = (t == nt - 2);
            if constexpr (Epi::HAS_MID) { if (t == 8 || t == 16) E.mid(acc, cur, t >> 3, wr, wc, fr, fq); }
            const char* a1 = cA + (size_t)(t + 1) * kstep;
            const char* a2 = last ? nA : cA + (size_t)(t + 2) * kstep; const char* b2 = last ? nB : cB + (size_t)(t + 2) * kstep;
            const char* a3 = a2 + kstep; const char* b3 = b2 + kstep;
            if (last && has_next) S.a_ready(nxt);
            if constexpr (SP2) {
            PG8_LDB(B0, 0, 0); PG8_LDB(B1, 0, 1); PG8_SCHED; PG8_LDA(At, 0, 0); PG8_STAGE(PG8_SA(1, 1), a1 + hstep, voffA);
            PG8_WAIT_V(8); PG8_WAIT_L(0); PG8_BAR; PG8_MMA(0, 0, At, B0); PG8_MMA(0, 1, At, B1); PG8_BAR; PG8_SCHED;
            PG8_LDA(At, 0, 1); PG8_STAGE(PG8_SB(0, 0), b2, voffB); PG8_STAGE(PG8_SB(0, 1), b2 + hstep, voffB); PG8_STAGE(PG8_SA(0, 0), a2, voffA);
            PG8_WAIT_V(8); PG8_WAIT_L(0); PG8_BAR; PG8_MMA(1, 0, At, B0); PG8_MMA(1, 1, At, B1); PG8_BAR; PG8_SCHED;
            PG8_LDB(B0, 1, 0); PG8_LDB(B1, 1, 1); PG8_SCHED; PG8_LDA(At, 1, 0); PG8_STAGE(PG8_SA(0, 1), a2 + hstep, voffA);
            PG8_WAIT_V(8); PG8_WAIT_L(0); PG8_BAR; PG8_MMA(0, 0, At, B0); PG8_MMA(0, 1, At, B1); PG8_BAR; PG8_SCHED;
            PG8_LDA(At, 1, 1); PG8_STAGE(PG8_SB(1, 0), b3, voffB); PG8_STAGE(PG8_SB(1, 1), b3 + hstep, voffB); PG8_STAGE(PG8_SA(1, 0), a3, voffA);
            PG8_WAIT_V(8); PG8_WAIT_L(0); PG8_BAR; PG8_MMA(1, 0, At, B0); PG8_MMA(1, 1, At, B1); PG8_BAR; PG8_SCHED;
            } else {
            PG8_LDB(B0, 0, 0); PG8_SCHED; PG8_LDA(At, 0, 0); PG8_STAGE(PG8_SA(1, 1), a1 + hstep, voffA);
            PG8_WAIT_L(8); PG8_BAR; PG8_WAIT_L(0); PG8_MMA(0, 0, At, B0); PG8_BAR; PG8_SCHED;
            PG8_LDB(B1, 0, 1); PG8_STAGE(PG8_SB(0, 0), b2, voffB);
            PG8_BAR; PG8_WAIT_L(0); PG8_MMA(0, 1, At, B1); PG8_BAR;
            PG8_LDA(At, 0, 1); PG8_STAGE(PG8_SA(0, 0), a2, voffA);
            PG8_BAR; PG8_WAIT_L(0); PG8_MMA(1, 0, At, B0); PG8_BAR; PG8_SCHED;
            PG8_STAGE(PG8_SB(0, 1), b2 + hstep, voffB);
            PG8_WAIT_V(6); PG8_BAR; PG8_MMA(1, 1, At, B1); PG8_BAR;
            PG8_LDB(B0, 1, 0); PG8_SCHED; PG8_LDA(At, 1, 0); PG8_STAGE(PG8_SA(0, 1), a2 + hstep, voffA);
            PG8_WAIT_L(8); PG8_BAR; PG8_WAIT_L(0); PG8_MMA(0, 0, At, B0); PG8_BAR; PG8_SCHED;
            PG8_LDB(B1, 1, 1); PG8_STAGE(PG8_SB(1, 0), b3, voffB);
            PG8_BAR; PG8_WAIT_L(0); PG8_MMA(0, 1, At, B1); PG8_BAR;
            PG8_LDA(At, 1, 1); PG8_STAGE(PG8_SA(1, 0), a3, voffA);
            PG8_BAR; PG8_WAIT_L(0); PG8_MMA(1, 0, At, B0); PG8_BAR; PG8_SCHED;
            PG8_STAGE(PG8_SB(1, 1), b3 + hstep, voffB);
            PG8_WAIT_V(6); PG8_BAR; PG8_MMA(1, 1, At, B1); PG8_BAR;
            }
        }
        if constexpr (ALIGN_EPI) { if (wr == 0) PG8_BAR; }
        if constexpr (!Epi::AFTER_DRAIN) { E(acc, cur, wr, wc, fr, fq); S.done(cur); }
        if (!has_next) break;
#pragma unroll
        for (int a = 0; a < 2; ++a)
#pragma unroll
            for (int b = 0; b < 2; ++b)
#pragma unroll
                for (int m = 0; m < 4; ++m)
#pragma unroll
                    for (int n = 0; n < 2; ++n) acc[a][b][m][n] = (f32x4){0.f, 0.f, 0.f, 0.f};
        cur = nxt; cA = nA; cB = nB; ++ui;
        if constexpr (ALIGN_EPI) { if (wr == 1) PG8_BAR; }
    }
    PG8_WAIT_V(0);
    if constexpr (!ALIGN_EPI) { if (wr == 0) PG8_BAR; }
    PG8_BAR;
    if constexpr (Epi::AFTER_DRAIN) { E.fused(acc, cur, wr, wc, fr, fq, lds, wid, lane); S.done(cur); }
#undef PG8_SA
#undef PG8_SB
#undef PG8_STAGE
#undef PG8_LDA
#undef PG8_LDB
#undef PG8_MMA
#undef PG8_WAIT_V
#undef PG8_WAIT_L
#undef PG8_BAR
#undef PG8_SCHED
}
}

#define LAS __attribute__((address_space(3)))
#define DI __device__ __forceinline__
typedef unsigned short bf16_t;
typedef short bf16x8 __attribute__((ext_vector_type(8)));
typedef float f32x4 __attribute__((ext_vector_type(4)));
typedef unsigned u32x4 __attribute__((ext_vector_type(4)));
typedef unsigned u32x2 __attribute__((ext_vector_type(2)));

constexpr int D = 1024, NB = 8, SEQ = 4096, DEPTH = 4, CTXL = 256;
constexpr int MX = NB * SEQ, MC = NB * CTXL, MT = MX + MC;
constexpr int NIN = 8208, NP = 3584, N1 = 5376, NG = 3072, FF = 2816, NW1 = N1 + NG;
constexpr float EPS = 1e-6f;
constexpr float LOG2E = 1.4426950408889634f;
constexpr size_t MiB = 1u << 20;
constexpr size_t WS_MOD = 0;
constexpr size_t WS_BIAS = 1 * MiB;
constexpr size_t WS_CTL = 5 * MiB;
constexpr size_t WS_LB = 1 * MiB + 262144;
constexpr size_t WS_MLG = 2 * MiB;
constexpr size_t WS_W = 6 * MiB;
constexpr size_t W_W1 = 0, W_BR = (size_t)NW1 * 1024 * 2, W_O = W_BR + 3ull * 1024 * 512 * 2, W_FI = W_O + 1024ull * 1024 * 2, W_FO = W_FI + 5632ull * 1024 * 2, W_END = W_FO + 1024ull * 2816 * 2;
constexpr size_t WS_CTXW = 46 * MiB;
constexpr size_t WS_AS = 54 * MiB;
constexpr size_t WS_SL = 122 * MiB;
constexpr size_t WS_BR = 156 * MiB;
constexpr size_t WS_P = 258 * MiB;
constexpr size_t WS_W2 = 258 * MiB + (size_t)MT * NP * 2;
constexpr size_t WS_END = WS_W2 + 39845888;
static_assert(W_END <= 39845888, "weights");
constexpr int LDS_BYTES = 155648;

DI float ex2(float x) { return __builtin_amdgcn_exp2f(x); }
DI float lg2(float x) { return __builtin_amdgcn_logf(x); }
DI float rcpf_(float x) { return __builtin_amdgcn_rcpf(x); }
DI float sigm(float x) { return rcpf_(1.f + ex2(-LOG2E * x)); }
DI float silu_(float x) { return x * sigm(x); }
DI float gelu_t(float x) { const float u = 1.5957691216f * (x + 0.044715f * x * x * x); return x * sigm(u); }
typedef __bf16 bf2_t __attribute__((ext_vector_type(2)));
DI unsigned pk2(float lo, float hi) { bf2_t v = { (__bf16)lo, (__bf16)hi }; return __builtin_bit_cast(unsigned, v); }
DI float bflo(unsigned w) { return __uint_as_float(w << 16); }
DI float bfhi(unsigned w) { return __uint_as_float(w & 0xffff0000u); }
DI float bf1(bf16_t h) { return __uint_as_float(((unsigned)h) << 16); }
DI float wave_sum(float v) {
#pragma unroll
    for (int o = 1; o < 64; o <<= 1) v += __shfl_xor(v, o);
    return v;
}
DI f32x4 mfma16(bf16x8 a, bf16x8 b, f32x4 c) { return __builtin_amdgcn_mfma_f32_16x16x32_bf16(a, b, c, 0, 0, 0); }
DI bf16x8 ldfrag(const LAS bf16_t* base, int ld, int r0, int k0, int lane) { return *(const LAS bf16x8*)(base + (r0 + (lane & 15)) * ld + k0 + (lane >> 4) * 8); }

DI int otid() { int t = threadIdx.x; asm volatile("" : "+v"(t)); return t; }
DI u32x4 ld16_coh(const void* p) { const unsigned long long a = __hip_atomic_load((const unsigned long long*)p, __ATOMIC_RELAXED, __HIP_MEMORY_SCOPE_AGENT), b = __hip_atomic_load((const unsigned long long*)p + 1, __ATOMIC_RELAXED, __HIP_MEMORY_SCOPE_AGENT);
    u32x4 r; r.x = (unsigned)a; r.y = (unsigned)(a >> 32); r.z = (unsigned)b; r.w = (unsigned)(b >> 32); return r; }
struct KArgs { const float* in[23]; float* out; unsigned char* ws; int run, pad1; };

enum { ACT_ID = 0, ACT_SILU = 1, ACT_LOG2F = 2, ACT_SCALE8 = 3, ACT_SIGM = 4, ACT_GELU = 5 };
struct Epi1 {
    static constexpr bool PERM = true, AFTER_DRAIN = false, HAS_MID = false;
    bf16_t* P; bf16_t* BR; float* MLG; const float* bias; const float* lb;
    DI void operator()(const f32x4 (&acc)[2][2][4][2], const pg8::Unit& u, int wr, int wc, int fr, int fq) const {
        const int pn = u.pn, row0 = u.pm * 256 + wr * 64 + fr;
        if (pn == 20) {
            if (wc == 0 && fq < 2) {
                const f32x4 b0 = *(const f32x4*)(bias + 5120 + 8 * fq), b1 = *(const f32x4*)(bias + 5120 + 8 * fq + 4);
#pragma unroll
                for (int ai = 0; ai < 2; ++ai)
#pragma unroll
                    for (int m = 0; m < 4; ++m) { float* dst = MLG + (size_t)(row0 + ai * 128 + m * 16) * 16 + 8 * fq;
                        *(f32x4*)dst = acc[ai][0][m][0] + b0; *(f32x4*)(dst + 4) = acc[ai][0][m][1] + b1; }
            }
            return;
        }
        int act, ldc, colt; bf16_t* base;
        if (pn < 14) { base = P; ldc = NP; colt = pn * 256; act = pn < 2 ? ACT_SILU : (pn < 4 ? ACT_ID : (pn < 8 ? ACT_LOG2F : (pn == 8 ? ACT_SCALE8 : ACT_ID))); }
        else { const int n = (pn - 14) >> 1; base = BR; ldc = 1536; colt = (pn - 14) * 256; act = n == 0 ? ACT_SILU : (n == 1 ? ACT_SIGM : ACT_GELU); }
        const int cin = wc * 32 + 8 * fq, bcol0 = pn * 256 + cin;
        bf16_t* tbase = base + (size_t)row0 * ldc + colt + cin;
        switch (act) {
            case ACT_SILU:   tile<ACT_SILU>(acc, tbase, ldc, bcol0); break;
            case ACT_LOG2F:  tile<ACT_LOG2F>(acc, tbase, ldc, bcol0); break;
            case ACT_SCALE8: tile<ACT_SCALE8>(acc, tbase, ldc, bcol0); break;
            case ACT_SIGM:   tile<ACT_SIGM>(acc, tbase, ldc, bcol0); break;
            case ACT_GELU:   tile<ACT_GELU>(acc, tbase, ldc, bcol0); break;
            default:         tile<ACT_ID>(acc, tbase, ldc, bcol0); break;
        }
    }
    template <int ACT> DI void tile(const f32x4 (&acc)[2][2][4][2], bf16_t* tbase, int ldc, int bcol0) const {
        f32x4 bv[2][2], lbv[2][2];
#pragma unroll
        for (int bj = 0; bj < 2; ++bj)
#pragma unroll
            for (int n = 0; n < 2; ++n) { bv[bj][n] = *(const f32x4*)(bias + bcol0 + bj * 128 + 4 * n);
                lbv[bj][n] = (ACT == ACT_LOG2F) ? *(const f32x4*)(lb + (bcol0 - 1024) + bj * 128 + 4 * n) : (f32x4){0.f, 0.f, 0.f, 0.f}; }
#pragma unroll
        for (int ai = 0; ai < 2; ++ai)
#pragma unroll
            for (int m = 0; m < 4; ++m) { bf16_t* rowp = tbase + (size_t)(ai * 128 + m * 16) * ldc;
#pragma unroll
                for (int bj = 0; bj < 2; ++bj) { f32x4 v[2];
#pragma unroll
                    for (int n = 0; n < 2; ++n) { v[n] = acc[ai][bj][m][n] + bv[bj][n];
#pragma unroll
                        for (int j = 0; j < 4; ++j) { float x = v[n][j];
                            if (ACT == ACT_SILU) x = silu_(x);
                            else if (ACT == ACT_LOG2F) { const float l = lbv[bj][n][j]; x = lg2(l + (1.f - l) * sigm(x)); }
                            else if (ACT == ACT_SCALE8) x *= 0.125f;
                            else if (ACT == ACT_SIGM) x = sigm(x);
                            else if (ACT == ACT_GELU) x = gelu_t(x);
                            v[n][j] = x; } }
                    u32x4 w; w.x = pk2(v[0][0], v[0][1]); w.y = pk2(v[0][2], v[0][3]); w.z = pk2(v[1][0], v[1][1]); w.w = pk2(v[1][2], v[1][3]);
                    *(u32x4*)(rowp + bj * 128) = w; } }
    }
};
struct Epi2 {
    static constexpr bool PERM = true, AFTER_DRAIN = false, HAS_MID = false;
    bf16_t* G; const float* bias;
    DI void operator()(const f32x4 (&acc)[2][2][4][2], const pg8::Unit& u, int wr, int wc, int fr, int fq) const {
        const int row0 = u.pm * 256 + wr * 64 + fr, col0 = u.pn * 256 + wc * 32 + 8 * fq;
        f32x4 bv[2][2];
#pragma unroll
        for (int bj = 0; bj < 2; ++bj)
#pragma unroll
            for (int n = 0; n < 2; ++n) bv[bj][n] = *(const f32x4*)(bias + col0 + bj * 128 + 4 * n);
#pragma unroll
        for (int ai = 0; ai < 2; ++ai)
#pragma unroll
            for (int m = 0; m < 4; ++m) { bf16_t* rowp = G + (size_t)(row0 + ai * 128 + m * 16) * NG + col0;
#pragma unroll
                for (int bj = 0; bj < 2; ++bj) { f32x4 v0 = acc[ai][bj][m][0] + bv[bj][0], v1 = acc[ai][bj][m][1] + bv[bj][1];
#pragma unroll
                    for (int j = 0; j < 4; ++j) { v0[j] = sigm(v0[j]); v1[j] = sigm(v1[j]); }
                    u32x4 w; w.x = pk2(v0[0], v0[1]); w.y = pk2(v0[2], v0[3]); w.z = pk2(v1[0], v1[1]); w.w = pk2(v1[2], v1[3]);
                    *(u32x4*)(rowp + bj * 128) = w; } }
    }
};
struct Epi3 {
    static constexpr bool PERM = true, AFTER_DRAIN = false, HAS_MID = true;
    const bf16_t* G; bf16_t* MG;
    DI void mid(f32x4 (&acc)[2][2][4][2], const pg8::Unit& u, int nb, int wr, int wc, int fr, int fq) const {
        int row0 = u.pm * 256 + wr * 64 + fr, col0 = u.pn * 256 + wc * 32 + 8 * fq;
        asm volatile("" : "+v"(row0), "+v"(col0));
#pragma unroll
        for (int ai = 0; ai < 2; ++ai)
#pragma unroll
            for (int mp = 0; mp < 1; ++mp) { u32x4 ga[4][2], gb[4][2];
#pragma unroll
                for (int mm = 0; mm < 4; ++mm) { const size_t r = (size_t)(row0 + ai * 128 + (4 * mp + mm) * 16);
#pragma unroll
                    for (int bj = 0; bj < 2; ++bj) { ga[mm][bj] = *(const u32x4*)(G + r * NG + (nb - 1) * 1024 + col0 + bj * 128); gb[mm][bj] = *(const u32x4*)(G + r * NG + nb * 1024 + col0 + bj * 128); } }
#pragma unroll
                for (int mm = 0; mm < 4; ++mm) { const int m = 4 * mp + mm;
#pragma unroll
                    for (int bj = 0; bj < 2; ++bj) { const u32x4 a = ga[mm][bj], bq = gb[mm][bj];
                        f32x4 a0 = acc[ai][bj][m][0], a1 = acc[ai][bj][m][1];
                        a0[0] *= bflo(a.x) * rcpf_(bflo(bq.x)); a0[1] *= bfhi(a.x) * rcpf_(bfhi(bq.x)); a0[2] *= bflo(a.y) * rcpf_(bflo(bq.y)); a0[3] *= bfhi(a.y) * rcpf_(bfhi(bq.y));
                        a1[0] *= bflo(a.z) * rcpf_(bflo(bq.z)); a1[1] *= bfhi(a.z) * rcpf_(bfhi(bq.z)); a1[2] *= bflo(a.w) * rcpf_(bflo(bq.w)); a1[3] *= bfhi(a.w) * rcpf_(bfhi(bq.w));
                        acc[ai][bj][m][0] = a0; acc[ai][bj][m][1] = a1; } }
                asm volatile("" ::: "memory"); }
    }
    DI void operator()(const f32x4 (&acc)[2][2][4][2], const pg8::Unit& u, int wr, int wc, int fr, int fq) const {
        const int row0 = u.pm * 256 + wr * 64 + fr, col0 = u.pn * 256 + wc * 32 + 8 * fq;
#pragma unroll
        for (int ai = 0; ai < 2; ++ai) { u32x4 gws[4][2];
#pragma unroll
            for (int m = 0; m < 4; ++m)
#pragma unroll
                for (int bj = 0; bj < 2; ++bj) gws[m][bj] = *(const u32x4*)(G + (size_t)(row0 + ai * 128 + m * 16) * NG + 2 * 1024 + col0 + bj * 128);
#pragma unroll
            for (int m = 0; m < 4; ++m) { const size_t r = (size_t)(row0 + ai * 128 + m * 16);
#pragma unroll
                for (int bj = 0; bj < 2; ++bj) { const u32x4 gw = gws[m][bj];
                    const f32x4 a0 = acc[ai][bj][m][0], a1 = acc[ai][bj][m][1];
                    u32x4 w; w.x = pk2(bflo(gw.x) * a0[0], bfhi(gw.x) * a0[1]); w.y = pk2(bflo(gw.y) * a0[2], bfhi(gw.y) * a0[3]); w.z = pk2(bflo(gw.z) * a1[0], bfhi(gw.z) * a1[1]); w.w = pk2(bflo(gw.w) * a1[2], bfhi(gw.w) * a1[3]);
                    *(u32x4*)(MG + r * 1024 + col0 + bj * 128) = w; } }
            asm volatile("" ::: "memory"); }
    }
};
struct EpiRes {
    static constexpr bool PERM = false, AFTER_DRAIN = false, HAS_MID = false;
    const float* xsrc; float* xdst; const float* csrc; float* cdst; const float* mod; int colmajor; float pscale; int b;
    DI void operator()(const f32x4 (&acc)[2][2][4][2], const pg8::Unit& u, int wr, int wc, int fr, int fq) const {
        const int rowt = u.pm * 256; const bool isx = rowt < 4096; const int bb = isx ? b : 8;
        const float* mrow = mod + bb * 6144; const int col0 = u.pn * 256 + wc * 32 + 4 * fq;
        f32x4 mv[2][2];
#pragma unroll
        for (int bj = 0; bj < 2; ++bj)
#pragma unroll
            for (int n = 0; n < 2; ++n) mv[bj][n] = *(const f32x4*)(mrow + col0 + bj * 128 + n * 16) * pscale;
#pragma unroll
        for (int ai = 0; ai < 2; ++ai)
#pragma unroll
            for (int mp = 0; mp < 1; ++mp) { const float* src[4]; float* dst[4]; f32x4 xin[4][2][2];
#pragma unroll
                for (int mm = 0; mm < 4; ++mm) { const int m = 4 * mp + mm; const int r = rowt + ai * 128 + wr * 64 + m * 16 + fr;
                    if (isx) { const int p = r; const int t = colmajor ? (((p & 63) << 6) | (p >> 6)) : p; const size_t off = ((size_t)(b * 4096 + t)) * 1024 + col0; src[mm] = xsrc + off; dst[mm] = xdst + off; }
                    else { const size_t off = (size_t)(b * 256 + (r - 4096)) * 1024 + col0; src[mm] = csrc + off; dst[mm] = cdst + off; }
#pragma unroll
                    for (int bj = 0; bj < 2; ++bj)
#pragma unroll
                        for (int n = 0; n < 2; ++n) xin[mm][bj][n] = *(const f32x4*)(src[mm] + bj * 128 + n * 16); }
#pragma unroll
                for (int mm = 0; mm < 4; ++mm) { const int m = 4 * mp + mm;
#pragma unroll
                    for (int bj = 0; bj < 2; ++bj)
#pragma unroll
                        for (int n = 0; n < 2; ++n) *(f32x4*)(dst[mm] + bj * 128 + n * 16) = xin[mm][bj][n] + mv[bj][n] * acc[ai][bj][m][n]; }
                asm volatile("" ::: "memory"); }
    }
};
struct Epi5 {
    static constexpr bool PERM = true, AFTER_DRAIN = false, HAS_MID = false;
    bf16_t* H;
    DI void operator()(const f32x4 (&acc)[2][2][4][2], const pg8::Unit& u, int wr, int wc, int fr, int fq) const {
        const int row0 = u.pm * 256 + wr * 64 + fr, col0 = u.pn * 128 + wc * 32 + 8 * fq;
#pragma unroll
        for (int ai = 0; ai < 2; ++ai)
#pragma unroll
            for (int m = 0; m < 4; ++m) { bf16_t* rowp = H + (size_t)(row0 + ai * 128 + m * 16) * FF + col0;
                f32x4 v0, v1;
#pragma unroll
                for (int j = 0; j < 4; ++j) { v0[j] = silu_(acc[ai][0][m][0][j]) * acc[ai][1][m][0][j]; v1[j] = silu_(acc[ai][0][m][1][j]) * acc[ai][1][m][1][j]; }
                u32x4 w; w.x = pk2(v0[0], v0[1]); w.y = pk2(v0[2], v0[3]); w.z = pk2(v1[0], v1[1]); w.w = pk2(v1[2], v1[3]);
                *(u32x4*)rowp = w; }
    }
};
template <class Epi> DI void run_gemm(LAS unsigned char* lds, const bf16_t* A, const bf16_t* Bt, int M, int N, int K, const Epi& E, int gr, int gs) {
    pg8::Gemm g{A, Bt, M, N, K}; pg8::StaticOrder S; S.init(M, N, gs, gr);
    pg8::gemm_phase<Epi, pg8::StaticOrder, PG8_ALIGN_V, PG8_SP2_V>(lds, g, S, E);
}

DI void phase_mod(const KArgs& a, LAS unsigned char* lds, float* MOD, float* LB) {
    LAS float* SC = (LAS float*)lds; LAS float* RED = SC + 9 * 1024;
    const int tid = otid(), lane = tid & 63, w = tid >> 6;
    for (int i = tid; i < 9 * 1024; i += 512) { const int r = i >> 10, k = i & 1023; const float v = r < 8 ? a.in[1][r * 1024 + k] : a.in[3][k]; SC[i] = v / (1.f + __expf(-v)); }
    __syncthreads();
    for (int u = blockIdx.x; u < 4 * 96; u += gridDim.x) {
        const int l = u / 96, n0 = (u % 96) * 64;
        const float* W = a.in[4] + (size_t)l * 1024 * 6144 + n0 + lane;
        float acc[9];
#pragma unroll
        for (int r = 0; r < 9; ++r) acc[r] = 0.f;
#pragma unroll 16
        for (int k = w * 128; k < w * 128 + 128; ++k) { const float wv = __builtin_nontemporal_load(&W[(size_t)k * 6144]);
#pragma unroll
            for (int r = 0; r < 9; ++r) acc[r] += SC[r * 1024 + k] * wv; }
#pragma unroll
        for (int r = 0; r < 9; ++r) RED[(w * 9 + r) * 64 + lane] = acc[r];
        __syncthreads();
        for (int i = tid; i < 9 * 64; i += 512) { const int r = i >> 6, c = i & 63; float s = 0.f;
#pragma unroll
            for (int ww = 0; ww < 8; ++ww) s += RED[(ww * 9 + r) * 64 + c];
            MOD[((size_t)l * 9 + r) * 6144 + n0 + c] = s + a.in[5][l * 6144 + n0 + c]; }
        __syncthreads();
    }
    for (int i = blockIdx.x * 512 + tid; i < 1024; i += gridDim.x * 512) {
        const float r0 = a.in[9][i], r1 = a.in[9][1024 + i], r2 = a.in[9][2048 + i], r3 = a.in[9][3072 + i];
        const float mx = fmaxf(fmaxf(r0, r1), fmaxf(r2, r3));
        const float e0 = __expf(r0 - mx), e1 = __expf(r1 - mx), e2 = __expf(r2 - mx), e3 = __expf(r3 - mx), inv = 1.f / (e0 + e1 + e2 + e3);
        LB[i] = 0.f; LB[1024 + i] = e1 * inv; LB[2048 + i] = (e1 + e2) * inv; LB[3072 + i] = (e1 + e2 + e3) * inv;
    }
}
DI int map_in(int n) {
    if (n < 1024) return n;
    if (n < 1536) return 3584 + (n - 1024);
    if (n < 2560) return 1024 + (n - 1536);
    if (n < 2816) return 2048 + (n - 2560);
    if (n < 3072) return 2304 + (n - 2816);
    if (n < 3584) return 2560 + (n - 3072);
    if (n < 4096) return 4096 + (n - 3584);
    if (n < 4112) return 5120 + (n - 4096);
    if (n < 4624) return 3072 + (n - 4112);
    if (n < 5136) return 4608 + (n - 4624);
    return 5376 + (n - 5136);
}
DI int map_ffn(int n) { return n < FF ? ((n >> 7) * 256 + (n & 127)) : (((n - FF) >> 7) * 256 + 128 + ((n - FF) & 127)); }
template <int MAP> DI void conv_item(const float* W, int K, int N, bf16_t* WT, LAS float* scr, int item, int lane, int ldk = 0) {
    if (ldk == 0) ldk = K;
    const int nblk = (N + 31) / 32, kb = item / nblk, nb = item % nblk, k0 = 64 * kb, n0 = 32 * nb;
    const int nn = n0 + (lane & 31); const bool ok = nn < N;
#pragma unroll 8
    for (int i = 0; i < 32; ++i) { const int kk = 2 * i + (lane >> 5); scr[kk * 33 + (lane & 31)] = ok ? __builtin_nontemporal_load(&W[(size_t)(k0 + kk) * N + nn]) : 0.f; }
    asm volatile("s_waitcnt lgkmcnt(0)" ::: "memory");
    const int c = lane & 7;
#pragma unroll
    for (int j = 0; j < 4; ++j) { const int nl = (lane >> 3) + 8 * j, n = n0 + nl;
        if (n < N) { const LAS float* s = scr + (8 * c) * 33 + nl;
            u32x4 o; o.x = pk2(s[0 * 33], s[1 * 33]); o.y = pk2(s[2 * 33], s[3 * 33]); o.z = pk2(s[4 * 33], s[5 * 33]); o.w = pk2(s[6 * 33], s[7 * 33]);
            const int dr = MAP == 1 ? map_in(n) : (MAP == 2 ? map_ffn(n) : n);
            *(u32x4*)(WT + (size_t)dr * ldk + k0 + 8 * c) = o; } }
    asm volatile("s_waitcnt lgkmcnt(0)" ::: "memory");
}
DI void phase_conv(const KArgs& a, LAS unsigned char* lds, int l, unsigned char* wsw, float* BIAS) {
    const int tid = otid(), lane = tid & 63, w = tid >> 6;
    LAS float* scr = (LAS float*)(lds + w * 16384);
    const int gw = blockIdx.x * 8 + w, NGW = gridDim.x * 8;
    constexpr int I_IN = 16 * 257, I_BR = 8 * 32, I_O = 16 * 32, I_FI = 16 * 176, I_FO = 44 * 32;
    constexpr int NIT = I_IN + 3 * I_BR + I_O + I_FI + I_FO;
    for (int it = gw; it < NIT; it += NGW) {
        int r = it;
        if (r < I_IN) { conv_item<1>(a.in[7] + (size_t)l * 1024 * NIN, 1024, NIN, (bf16_t*)(wsw + W_W1), scr, r, lane); continue; } r -= I_IN;
        if (r < 3 * I_BR) { const int n = r / I_BR; conv_item<0>(a.in[17] + ((size_t)l * 3 + n) * 512 * 1024, 512, 1024, (bf16_t*)(wsw + W_BR) + (size_t)n * 512, scr, r % I_BR, lane, 1536); continue; } r -= 3 * I_BR;
        if (r < I_O) { conv_item<0>(a.in[18] + (size_t)l * 1024 * 1024, 1024, 1024, (bf16_t*)(wsw + W_O), scr, r, lane); continue; } r -= I_O;
        if (r < I_FI) { conv_item<2>(a.in[20] + (size_t)l * 1024 * 2 * FF, 1024, 2 * FF, (bf16_t*)(wsw + W_FI), scr, r, lane); continue; } r -= I_FI;
        conv_item<0>(a.in[21] + (size_t)l * FF * 1024, FF, 1024, (bf16_t*)(wsw + W_FO), scr, r, lane);
    }
    for (int i = blockIdx.x * 512 + tid; i < NIN; i += gridDim.x * 512) BIAS[(size_t)l * NW1 + map_in(i)] = a.in[8][(size_t)l * NIN + i];
    for (int i = blockIdx.x * 512 + tid; i < 240; i += gridDim.x * 512) BIAS[(size_t)l * NW1 + 5136 + i] = 0.f;
}
DI void phase_conv_q(const KArgs& a, LAS unsigned char* lds, int l, unsigned char* wsw, float* BIAS, unsigned* q) {
    const int tid = otid(), lane = tid & 63, w = tid >> 6;
    LAS float* scr = (LAS float*)(lds + w * 16384);
    constexpr int I_IN = 16 * 257, I_BR = 8 * 32, I_O = 16 * 32, I_FI = 16 * 176, I_FO = 44 * 32;
    constexpr int NIT = I_IN + 3 * I_BR + I_O + I_FI + I_FO;
    for (;;) {
        unsigned itv = 0u; if (lane == 0) itv = __hip_atomic_fetch_add(q, 1u, __ATOMIC_RELAXED, __HIP_MEMORY_SCOPE_AGENT);
        const int it = __builtin_amdgcn_readfirstlane((int)itv);
        if (it >= NIT + 18) break;
        int r = it;
        if (r >= NIT) { r -= NIT;
            if (r < 17) {
#pragma unroll
                for (int k = 0; k < 8; ++k) { const int i = r * 512 + k * 64 + lane; if (i < NIN) BIAS[(size_t)l * NW1 + map_in(i)] = a.in[8][(size_t)l * NIN + i]; } }
            else {
#pragma unroll
                for (int k = 0; k < 4; ++k) { const int i = k * 64 + lane; if (i < 240) BIAS[(size_t)l * NW1 + 5136 + i] = 0.f; } }
            continue; }
        if (r < I_IN) { conv_item<1>(a.in[7] + (size_t)l * 1024 * NIN, 1024, NIN, (bf16_t*)(wsw + W_W1), scr, r, lane); continue; } r -= I_IN;
        if (r < 3 * I_BR) { const int n = r / I_BR; conv_item<0>(a.in[17] + ((size_t)l * 3 + n) * 512 * 1024, 512, 1024, (bf16_t*)(wsw + W_BR) + (size_t)n * 512, scr, r % I_BR, lane, 1536); continue; } r -= 3 * I_BR;
        if (r < I_O) { conv_item<0>(a.in[18] + (size_t)l * 1024 * 1024, 1024, 1024, (bf16_t*)(wsw + W_O), scr, r, lane); continue; } r -= I_O;
        if (r < I_FI) { conv_item<2>(a.in[20] + (size_t)l * 1024 * 2 * FF, 1024, 2 * FF, (bf16_t*)(wsw + W_FI), scr, r, lane); continue; } r -= I_FI;
        conv_item<0>(a.in[21] + (size_t)l * FF * 1024, FF, 1024, (bf16_t*)(wsw + W_FO), scr, r, lane);
    }
}
DI void norm_row(const float* src, const float* lnw, const float* shift, const float* scale, bf16_t* dst, int lane) {
    const f32x4* xr = (const f32x4*)src + lane; f32x4 v[4]; float s = 0.f;
#pragma unroll
    for (int j = 0; j < 4; ++j) { v[j] = xr[64 * j]; s += (v[j].x * v[j].x + v[j].y * v[j].y) + (v[j].z * v[j].z + v[j].w * v[j].w); }
    const float rstd = rsqrtf(wave_sum(s) * (1.f / D) + EPS);
#pragma unroll
    for (int j = 0; j < 4; ++j) { const int c = 4 * lane + 256 * j; const f32x4 w = *(const f32x4*)(lnw + c), sh = *(const f32x4*)(shift + c), sc = *(const f32x4*)(scale + c);
        const f32x4 y = v[j] * rstd * w * (sc + 1.f) + sh; u32x2 o; o.x = pk2(y.x, y.y); o.y = pk2(y.z, y.w); *(u32x2*)(dst + c) = o; }
}
DI const float* src_row(int m, int b, const float* xs, const float* cs, int colmajor, int& modrow) {
    if (m < 4096) { const int p = m, t = colmajor ? (((p & 63) << 6) | (p >> 6)) : p; modrow = b; return xs + ((size_t)(b * 4096 + t)) * 1024; }
    modrow = 8; return cs + (size_t)(b * 256 + (m - 4096)) * 1024;
}
DI void phase_norm(const float* xs, const float* cs, const float* lnw, const float* modl, int ksh, int ksc, int colmajor, bf16_t* AS, int Mrows, int b, int gr, int gs) {
    const int tid = otid(); const int lane = tid & 63, gw = gr * 8 + (tid >> 6), NGW = gs * 8;
    f32x4 wf[4], sf[4], nv[4]; int curmr = -1; int m = gw;
    if (m < Mrows) { int mr; const f32x4* xr = (const f32x4*)src_row(m, b, xs, cs, colmajor, mr) + lane;
#pragma unroll
        for (int j = 0; j < 4; ++j) nv[j] = __builtin_nontemporal_load(&xr[64 * j]); }
    while (m < Mrows) {
        f32x4 v[4];
#pragma unroll
        for (int j = 0; j < 4; ++j) v[j] = nv[j];
        const int mr = (m < 4096) ? b : 8, mn = m + NGW;
        if (mn < Mrows) { int mr2; const f32x4* xr = (const f32x4*)src_row(mn, b, xs, cs, colmajor, mr2) + lane;
#pragma unroll
            for (int j = 0; j < 4; ++j) nv[j] = __builtin_nontemporal_load(&xr[64 * j]); }
        if (mr != curmr) { curmr = mr;
#pragma unroll
            for (int j = 0; j < 4; ++j) { const int c = 4 * lane + 256 * j; wf[j] = *(const f32x4*)(lnw + c) * (*(const f32x4*)(modl + mr * 6144 + ksc * 1024 + c) + 1.f); sf[j] = *(const f32x4*)(modl + mr * 6144 + ksh * 1024 + c); } }
        float s = 0.f;
#pragma unroll
        for (int j = 0; j < 4; ++j) s += (v[j].x * v[j].x + v[j].y * v[j].y) + (v[j].z * v[j].z + v[j].w * v[j].w);
        const float rstd = rsqrtf(wave_sum(s) * (1.f / D) + EPS);
        bf16_t* dst = AS + (size_t)m * 1024;
#pragma unroll
        for (int j = 0; j < 4; ++j) { const f32x4 y = v[j] * rstd * wf[j] + sf[j]; u32x2 o; o.x = pk2(y.x, y.y); o.y = pk2(y.z, y.w); *(u32x2*)(dst + 4 * lane + 256 * j) = o; }
        m = mn;
    }
}
DI void phase_fin(const float* xs, const float* cs, const float* lnw, const float* modl, int colmajor, bf16_t* AS, bf16_t* SL, bf16_t* BR, const float* hgn, const float* mln, int Mrows, int b, int gr, int gs) {
    const int tid = otid(); const int lane = tid & 63, gw = gr * 8 + (tid >> 6), NGW = gs * 8;
    const int cb = (16 * lane) & 511; const float* nwp = (lane < 32 ? hgn : mln) + cb;
    f32x4 nw4[4];
#pragma unroll
    for (int j = 0; j < 4; ++j) nw4[j] = *(const f32x4*)(nwp + 4 * j);
    f32x4 wf[4], sf[4]; int curmr = -1; int m = gw;
    u32x4 ns0, ns1, ng0, ng1, nsl, ng2; f32x4 nv[4];
#define FIN_LOAD(mm) do { const bf16_t* ap = AS + (size_t)(mm) * 1024 + 16 * lane; ns0 = *(const u32x4*)ap; ns1 = *(const u32x4*)(ap + 8); const bf16_t* gp_ = BR + (size_t)(mm) * 1536 + 16 * lane; ng0 = *(const u32x4*)gp_; ng1 = *(const u32x4*)(gp_ + 8); \
        nsl = *(const u32x4*)(SL + (size_t)(mm) * 512 + 8 * lane); ng2 = *(const u32x4*)(BR + (size_t)(mm) * 1536 + 1024 + 8 * lane); \
        int mr_; const f32x4* xr = (const f32x4*)src_row((mm), b, xs, cs, colmajor, mr_) + lane; _Pragma("unroll") for (int j = 0; j < 4; ++j) nv[j] = __builtin_nontemporal_load(&xr[64 * j]); } while (0)
    if (m < Mrows) FIN_LOAD(m);
    while (m < Mrows) {
        const u32x4 s0 = ns0, s1 = ns1, g0 = ng0, g1 = ng1, sl = nsl, g2 = ng2; f32x4 v[4];
#pragma unroll
        for (int j = 0; j < 4; ++j) v[j] = nv[j];
        const int mr = (m < 4096) ? b : 8, mn = m + NGW;
        if (mn < Mrows) FIN_LOAD(mn);
        if (mr != curmr) { curmr = mr;
#pragma unroll
            for (int j = 0; j < 4; ++j) { const int c = 4 * lane + 256 * j; wf[j] = *(const f32x4*)(lnw + c) * (*(const f32x4*)(modl + mr * 6144 + 1024 + c) + 1.f); sf[j] = *(const f32x4*)(modl + mr * 6144 + c); } }
        {
            float sv[16] = { bflo(s0.x), bfhi(s0.x), bflo(s0.y), bfhi(s0.y), bflo(s0.z), bfhi(s0.z), bflo(s0.w), bfhi(s0.w), bflo(s1.x), bfhi(s1.x), bflo(s1.y), bfhi(s1.y), bflo(s1.z), bfhi(s1.z), bflo(s1.w), bfhi(s1.w) };
            float ss = 0.f;
#pragma unroll
            for (int j = 0; j < 16; ++j) ss += sv[j] * sv[j];
            ss += __shfl_xor(ss, 1); ss += __shfl_xor(ss, 2); ss += __shfl_xor(ss, 4);
            const float rstd = rsqrtf(ss * (1.f / 128.f) + EPS);
            const float g[16] = { bflo(g0.x), bfhi(g0.x), bflo(g0.y), bfhi(g0.y), bflo(g0.z), bfhi(g0.z), bflo(g0.w), bfhi(g0.w), bflo(g1.x), bfhi(g1.x), bflo(g1.y), bfhi(g1.y), bflo(g1.z), bfhi(g1.z), bflo(g1.w), bfhi(g1.w) };
            float o[16];
#pragma unroll
            for (int j = 0; j < 16; ++j) o[j] = sv[j] * rstd * nw4[j >> 2][j & 3] * g[j];
            u32x4 w0, w1; w0.x = pk2(o[0], o[1]); w0.y = pk2(o[2], o[3]); w0.z = pk2(o[4], o[5]); w0.w = pk2(o[6], o[7]); w1.x = pk2(o[8], o[9]); w1.y = pk2(o[10], o[11]); w1.z = pk2(o[12], o[13]); w1.w = pk2(o[14], o[15]);
            bf16_t* gp = BR + (size_t)m * 1536 + 16 * lane; ((u32x4*)gp)[0] = w0; ((u32x4*)gp)[1] = w1;
        }
        {
            u32x4 w; w.x = pk2(bflo(sl.x) * bflo(g2.x), bfhi(sl.x) * bfhi(g2.x)); w.y = pk2(bflo(sl.y) * bflo(g2.y), bfhi(sl.y) * bfhi(g2.y)); w.z = pk2(bflo(sl.z) * bflo(g2.z), bfhi(sl.z) * bfhi(g2.z)); w.w = pk2(bflo(sl.w) * bflo(g2.w), bfhi(sl.w) * bfhi(g2.w));
            *(u32x4*)(BR + (size_t)m * 1536 + 1024 + 8 * lane) = w;
        }
        {
            float s = 0.f;
#pragma unroll
            for (int j = 0; j < 4; ++j) s += (v[j].x * v[j].x + v[j].y * v[j].y) + (v[j].z * v[j].z + v[j].w * v[j].w);
            const float rstd = rsqrtf(wave_sum(s) * (1.f / D) + EPS);
            bf16_t* dst = AS + (size_t)m * 1024;
#pragma unroll
            for (int j = 0; j < 4; ++j) { const f32x4 y = v[j] * rstd * wf[j] + sf[j]; u32x2 o2; o2.x = pk2(y.x, y.y); o2.y = pk2(y.z, y.w); *(u32x2*)(dst + 4 * lane + 256 * j) = o2; }
        }
        m = mn;
    }
#undef FIN_LOAD
}
DI void phase_final(float* out, const float* fw, int gr, int gs) {
    const int tid = otid(); const int lane = tid & 63, gw = gr * 8 + (tid >> 6), NGW = gs * 8;
    f32x4 wv[4], nv[4];
#pragma unroll
    for (int j = 0; j < 4; ++j) wv[j] = *(const f32x4*)(fw + 4 * lane + 256 * j);
    int m = gw;
    if (m < 4096) { const f32x4* xr = (const f32x4*)(out + (size_t)m * 1024) + lane;
#pragma unroll
        for (int j = 0; j < 4; ++j) nv[j] = __builtin_nontemporal_load(&xr[64 * j]); }
    while (m < 4096) { f32x4 v[4]; float s = 0.f;
#pragma unroll
        for (int j = 0; j < 4; ++j) { v[j] = nv[j]; s += (v[j].x * v[j].x + v[j].y * v[j].y) + (v[j].z * v[j].z + v[j].w * v[j].w); }
        const int mn = m + NGW;
        if (mn < 4096) { const f32x4* xr = (const f32x4*)(out + (size_t)mn * 1024) + lane;
#pragma unroll
            for (int j = 0; j < 4; ++j) nv[j] = __builtin_nontemporal_load(&xr[64 * j]); }
        const float rstd = rsqrtf(wave_sum(s) * (1.f / D) + EPS);
        f32x4* xo = (f32x4*)(out + (size_t)m * 1024) + lane;
#pragma unroll
        for (int j = 0; j < 4; ++j) xo[64 * j] = v[j] * rstd * wv[j];
        m = mn; }
}

struct ScanArgs { const bf16_t* P; const float* MLG; bf16_t* AS; bf16_t* SL; const float* convw; const float* convb; const float* gw; const float* gb; const float* lam; int last; };
DI void chunk_geom(int j, int b, int dir, int& rowbase, int& pos0, int& slen, bool& first, bool& isx) {
    isx = j >= 4; const int cj = isx ? j - 4 : j, nch = isx ? 64 : 4, pc = dir ? nch - 1 - cj : cj;
    pos0 = pc * 64; slen = nch * 64; rowbase = (isx ? 0 : 4096) + pc * 64; first = cj < nch / 2; (void)b;
}
DI void out_rmw4(bf16_t* p, f32x4 v, bool first) {
    if (!first) { const unsigned long long w = __hip_atomic_load((unsigned long long*)p, __ATOMIC_RELAXED, __HIP_MEMORY_SCOPE_AGENT); const unsigned lo = (unsigned)w, hi = (unsigned)(w >> 32);
        v[0] += bflo(lo); v[1] += bfhi(lo); v[2] += bflo(hi); v[3] += bfhi(hi); }
    u32x2 o; o.x = pk2(v[0], v[1]); o.y = pk2(v[2], v[3]); *(u32x2*)p = o;
}
DI unsigned long long ld8_coh(const bf16_t* p) { return __hip_atomic_load((const unsigned long long*)p, __ATOMIC_RELAXED, __HIP_MEMORY_SCOPE_AGENT); }
DI void out_put4(bf16_t* p, f32x4 v, int mode, unsigned long long pre) {
    if (mode != 0) { const unsigned long long w = pre; const unsigned lo = (unsigned)w, hi = (unsigned)(w >> 32);
        v[0] += bflo(lo); v[1] += bfhi(lo); v[2] += bflo(hi); v[3] += bfhi(hi); }
    u32x2 o; o.x = pk2(v[0], v[1]); o.y = pk2(v[2], v[3]); *(u32x2*)p = o;
}
DI int pre_mode(bool first, int jn) { (void)jn; return first ? 0 : 1; }
DI bool late_pre(int jn) { return jn == 2 || jn == 36; }
constexpr int NSTEP = 68;
constexpr float ECLAMP = 120.f;

#define LBAR() do { asm volatile("s_waitcnt lgkmcnt(0)" ::: "memory"); __builtin_amdgcn_s_barrier(); asm volatile("" ::: "memory"); } while (0)
DI void scan_hgrn2(const ScanArgs& A, LAS unsigned char* lds, int unit) {
    const int tid = otid(), dir = tid >> 8, ht = tid & 255, hw = ht >> 6, lane = tid & 63, fr = lane & 15, fq = lane >> 4;
    const int b = 0, h = (unit >> 2) & 3, vs = unit & 3;
    LAS unsigned char* L = lds + dir * 76800;
    LAS bf16_t* Qt = (LAS bf16_t*)L;
    LAS bf16_t* Kt = Qt + 64 * 136;
    LAS bf16_t* KtT = Kt + 64 * 136;
    LAS bf16_t* Vt = KtT + 128 * 72;
    LAS bf16_t* Sc = Vt + 32 * 72;
    LAS bf16_t* Sb = Sc + 64 * 72;
    LAS float* GT = (LAS float*)Sc;
    LAS float* E2 = (LAS float*)(Sb + 32 * 136);
    LAS float* DEC = E2 + 128;
    const bf16_t* Pq = A.P + h * 128 + 2 * lane;
    const bf16_t* Pf = A.P + 1024 + dir * 512 + h * 128 + 2 * lane;
    const bf16_t* Pv = A.P + 512 + h * 128 + vs * 32 + (ht & 3) * 8;
    unsigned qw[16], fw[16]; u32x4 vv; unsigned long long pr[2] = {0ull, 0ull}; int pmode = 0;
    bf16_t* const opb = A.AS + h * 128 + vs * 32 + 4 * fq;
    f32x4 S[2][2];
#pragma unroll
    for (int a = 0; a < 2; ++a)
#pragma unroll
        for (int c = 0; c < 2; ++c) S[a][c] = (f32x4){0.f, 0.f, 0.f, 0.f};
    int rowbase, pos0, slen; bool first, isx;
    chunk_geom(0, b, dir, rowbase, pos0, slen, first, isx);
#define HG_LOAD() do { \
        _Pragma("unroll") for (int i = 0; i < 16; ++i) { const int t = 16 * hw + i; const size_t r = (size_t)(rowbase + (dir ? 63 - t : t)) * NP; qw[i] = *(const unsigned*)(Pq + r); fw[i] = *(const unsigned*)(Pf + r); } \
        { const int t = ht >> 2; vv = *(const u32x4*)(Pv + (size_t)(rowbase + (dir ? 63 - t : t)) * NP); } \
        if (pmode == 1 && !late_pre(jnx)) { const int t = 16 * hw + fr; const bf16_t* op = opb + (size_t)(rowbase + (dir ? 63 - t : t)) * 1024; pr[0] = ld8_coh(op); pr[1] = ld8_coh(op + 16); } } while (0)
    int jnx = 0;
    pmode = (A.last && !isx) ? 0 : pre_mode(first, 0);
    HG_LOAD();
    for (int j = 0; j < NSTEP; ++j) {
        const int orow = rowbase; const bool owrite = !(A.last && !isx); const int omode = pmode;
        if (late_pre(j) && pmode == 1) { const int t = 16 * hw + fr; const bf16_t* op = opb + (size_t)(rowbase + (dir ? 63 - t : t)) * 1024; pr[0] = ld8_coh(op); pr[1] = ld8_coh(op + 16); }
        unsigned long long opr0 = pr[0], opr1 = pr[1];
        asm volatile("" : "+v"(opr0), "+v"(opr1));
        float c0[16], c1[16]; float r0 = 0.f, r1 = 0.f;
#pragma unroll
        for (int i = 0; i < 16; ++i) { r0 += bflo(fw[i]); r1 += bfhi(fw[i]); c0[i] = r0; c1[i] = r1; }
        GT[hw * 128 + 2 * lane] = r0; GT[hw * 128 + 2 * lane + 1] = r1;
        { const int t = ht >> 2, v0 = (ht & 3) * 8; const unsigned vw[4] = {vv.x, vv.y, vv.z, vv.w};
#pragma unroll
            for (int e = 0; e < 4; ++e) { Vt[(v0 + 2 * e) * 72 + t] = (bf16_t)(vw[e] & 0xffffu); Vt[(v0 + 2 * e + 1) * 72 + t] = (bf16_t)(vw[e] >> 16); } }
        LBAR();
        {
            const float g00 = GT[2 * lane], g01 = GT[128 + 2 * lane], g02 = GT[256 + 2 * lane], g03 = GT[384 + 2 * lane];
            const float g10 = GT[2 * lane + 1], g11 = GT[128 + 2 * lane + 1], g12 = GT[256 + 2 * lane + 1], g13 = GT[384 + 2 * lane + 1];
            const float ref0 = g00 + g01, ref1 = g10 + g11, tot0 = ref0 + g02 + g03, tot1 = ref1 + g12 + g13;
            const float pre0 = hw == 0 ? 0.f : (hw == 1 ? g00 : (hw == 2 ? ref0 : ref0 + g02));
            const float pre1 = hw == 0 ? 0.f : (hw == 1 ? g10 : (hw == 2 ? ref1 : ref1 + g12));
            unsigned kp0[8], kp1[8];
            const float bs0 = fminf(fmaxf(pre0 - ref0, -ECLAMP), ECLAMP), bs1 = fminf(fmaxf(pre1 - ref1, -ECLAMP), ECLAMP);
            const float sq0 = ex2(bs0), sk0 = ex2(-bs0), sq1 = ex2(bs1), sk1 = ex2(-bs1);
            float E0 = 1.f, E1 = 1.f;
#pragma unroll
            for (int i = 0; i < 16; ++i) {
                const int t = 16 * hw + i;
                const float f0 = ex2(bflo(fw[i])), f1 = ex2(bfhi(fw[i]));
                E0 *= f0; E1 *= f1;
                const float eq0 = sq0 * E0, eq1 = sq1 * E1;
                const float ek0 = fminf(sk0 * rcpf_(E0), 1.3e36f), ek1 = fminf(sk1 * rcpf_(E1), 1.3e36f);
                const float q0 = bflo(qw[i]) * eq0, q1 = bfhi(qw[i]) * eq1;
                const float k0 = (1.f - f0) * ek0, k1 = (1.f - f1) * ek1;
                *(LAS unsigned*)(Qt + t * 136 + 2 * lane) = pk2(q0, q1);
                const unsigned kk = pk2(k0, k1);
                *(LAS unsigned*)(Kt + t * 136 + 2 * lane) = kk;
                if (i & 1) { kp0[i >> 1] |= (kk << 16); kp1[i >> 1] |= (kk & 0xffff0000u); } else { kp0[i >> 1] = kk & 0xffffu; kp1[i >> 1] = kk >> 16; }
            }
            { u32x4 w; w.x = kp0[0]; w.y = kp0[1]; w.z = kp0[2]; w.w = kp0[3]; *(LAS u32x4*)(KtT + (2 * lane) * 72 + 16 * hw) = w; w.x = kp0[4]; w.y = kp0[5]; w.z = kp0[6]; w.w = kp0[7]; *(LAS u32x4*)(KtT + (2 * lane) * 72 + 16 * hw + 8) = w;
              w.x = kp1[0]; w.y = kp1[1]; w.z = kp1[2]; w.w = kp1[3]; *(LAS u32x4*)(KtT + (2 * lane + 1) * 72 + 16 * hw) = w; w.x = kp1[4]; w.y = kp1[5]; w.z = kp1[6]; w.w = kp1[7]; *(LAS u32x4*)(KtT + (2 * lane + 1) * 72 + 16 * hw + 8) = w; }
            if (hw == 0) { E2[2 * lane] = ex2(tot0 - ref0); E2[2 * lane + 1] = ex2(tot1 - ref1); DEC[2 * lane] = ex2(tot0); DEC[2 * lane + 1] = ex2(tot1); }
#pragma unroll
            for (int a = 0; a < 2; ++a) { const int kb = 16 * (2 * hw + a) + 4 * fq; float sc4[4];
#pragma unroll
                for (int i = 0; i < 4; ++i) sc4[i] = ex2(GT[kb + i] + GT[128 + kb + i]);
#pragma unroll
                for (int c = 0; c < 2; ++c) { u32x2 w; w.x = pk2(S[a][c][0] * sc4[0], S[a][c][1] * sc4[1]); w.y = pk2(S[a][c][2] * sc4[2], S[a][c][3] * sc4[3]); *(LAS u32x2*)(Sb + (16 * c + fr) * 136 + kb) = w; } }
        }
        LBAR();
        if (j + 1 < NSTEP) { chunk_geom(j + 1, b, dir, rowbase, pos0, slen, first, isx); pmode = (A.last && !isx) ? 0 : pre_mode(first, j + 1); jnx = j + 1; HG_LOAD(); }
#pragma unroll
        for (int st = 0; st < 4; ++st) {
            f32x4 acc = (f32x4){0.f, 0.f, 0.f, 0.f};
            if (st <= hw) {
#pragma unroll
                for (int kk = 0; kk < 4; ++kk) acc = mfma16(ldfrag(Kt, 136, 16 * st, 32 * kk, lane), ldfrag(Qt, 136, 16 * hw, 32 * kk, lane), acc);
                if (st == hw) {
#pragma unroll
                    for (int i = 0; i < 4; ++i) acc[i] = (4 * fq + i <= fr) ? acc[i] : 0.f;
                }
            }
            u32x2 w; w.x = pk2(acc[0], acc[1]); w.y = pk2(acc[2], acc[3]);
            *(LAS u32x2*)(Sc + (16 * hw + fr) * 72 + 16 * st + 4 * fq) = w;
        }
        {
            const int t = 16 * hw + fr; bf16_t* op = opb + (size_t)(orow + (dir ? 63 - t : t)) * 1024;
#pragma unroll
            for (int c = 0; c < 2; ++c) { f32x4 acc = (f32x4){0.f, 0.f, 0.f, 0.f};
#pragma unroll
                for (int ks = 0; ks < 2; ++ks) acc = mfma16(ldfrag(Vt, 72, 16 * c, 32 * ks, lane), ldfrag(Sc, 72, 16 * hw, 32 * ks, lane), acc);
#pragma unroll
                for (int kk = 0; kk < 4; ++kk) acc = mfma16(ldfrag(Sb, 136, 16 * c, 32 * kk, lane), ldfrag(Qt, 136, 16 * hw, 32 * kk, lane), acc);
                if (owrite) out_put4(op + 16 * c, acc, omode, c == 0 ? opr0 : opr1); }
        }
#pragma unroll
        for (int a = 0; a < 2; ++a) { const int kb = 16 * (2 * hw + a);
            f32x4 dk, ek;
#pragma unroll
            for (int i = 0; i < 4; ++i) { dk[i] = DEC[kb + 4 * fq + i]; ek[i] = E2[kb + 4 * fq + i]; }
#pragma unroll
            for (int c = 0; c < 2; ++c) { f32x4 d = (f32x4){0.f, 0.f, 0.f, 0.f};
#pragma unroll
                for (int ks = 0; ks < 2; ++ks) d = mfma16(ldfrag(KtT, 72, kb, 32 * ks, lane), ldfrag(Vt, 72, 16 * c, 32 * ks, lane), d);
                S[a][c] = S[a][c] * dk + d * ek; } }
        if (j == 1 || j == 35) asm volatile("s_waitcnt vmcnt(0)" ::: "memory");
        LBAR();
    }
#undef HG_LOAD
}

DI void scan_mlstm(const ScanArgs& A, LAS unsigned char* lds, int unit) {
    const int tid = otid(), dir = tid >> 8, ht = tid & 255, hw = ht >> 6, lane = tid & 63, fr = lane & 15, fq = lane >> 4;
    const int b = 0, h = (unit >> 1) & 3, vs = unit & 1;
    LAS unsigned char* L = lds + dir * 63488;
    LAS bf16_t* Qs = (LAS bf16_t*)L;
    LAS bf16_t* Ks = Qs + 64 * 72;
    LAS bf16_t* KhT = Ks + 64 * 72;
    LAS bf16_t* Vt = KhT + 64 * 72;
    LAS bf16_t* Sc = Vt + 80 * 72;
    LAS bf16_t* Cb = Sc + 64 * 72;
    LAS float* G2 = (LAS float*)(Cb + 80 * 72);
    LAS float* M2 = G2 + 64; LAS float* WI = M2 + 64; LAS float* EM = WI + 64; LAS float* WS = EM + 64; LAS float* MISC = WS + 64;
    for (int i = ht; i < 16 * 72; i += 256) Vt[64 * 72 + i] = (i < 72) ? (bf16_t)0x3F80u : (bf16_t)0u;
    const int t_ld = ht >> 2, cg = ht & 3;
    const bf16_t* Pq = A.P + 2048 + h * 64 + cg * 16;
    const bf16_t* Pk = A.P + 2304 + h * 64 + cg * 16;
    const bf16_t* Pv = A.P + 2560 + h * 128 + vs * 64 + cg * 16;
    u32x4 rq[2], rk[2], rv[2]; float rig = 0.f, rfg = 0.f; unsigned long long pr[4] = {0ull, 0ull, 0ull, 0ull}; int pmode = 0;
    bf16_t* const opb = A.AS + 512 + h * 128 + vs * 64 + 4 * fq;
    f32x4 C[5];
#pragma unroll
    for (int c = 0; c < 5; ++c) C[c] = (f32x4){0.f, 0.f, 0.f, 0.f};
    float m2prev = 0.f;
    int rowbase, pos0, slen; bool first, isx;
    chunk_geom(0, b, dir, rowbase, pos0, slen, first, isx);
#define ML_LOAD() do { const size_t r = (size_t)(rowbase + (dir ? 63 - t_ld : t_ld)) * NP; \
        rq[0] = *(const u32x4*)(Pq + r); rq[1] = *(const u32x4*)(Pq + r + 8); rk[0] = *(const u32x4*)(Pk + r); rk[1] = *(const u32x4*)(Pk + r + 8); rv[0] = *(const u32x4*)(Pv + r); rv[1] = *(const u32x4*)(Pv + r + 8); \
        if (hw == 0) { const float* g = A.MLG + (size_t)(rowbase + (dir ? 63 - lane : lane)) * 16 + dir * 4 + h; rig = g[0]; rfg = g[8]; } \
        if (pmode == 1 && !late_pre(jnx)) { const int t = 16 * hw + fr; const bf16_t* op = opb + (size_t)(rowbase + (dir ? 63 - t : t)) * 1024; _Pragma("unroll") for (int c = 0; c < 4; ++c) pr[c] = ld8_coh(op + 16 * c); } } while (0)
    int jnx = 0;
    pmode = (A.last && !isx) ? 0 : pre_mode(first, 0);
    ML_LOAD();
    for (int j = 0; j < NSTEP; ++j) {
        const int orow = rowbase; const bool owrite = !(A.last && !isx); const int omode = pmode;
        if (late_pre(j) && pmode == 1) { const int t = 16 * hw + fr; const bf16_t* op = opb + (size_t)(rowbase + (dir ? 63 - t : t)) * 1024; _Pragma("unroll") for (int c = 0; c < 4; ++c) pr[c] = ld8_coh(op + 16 * c); }
        unsigned long long opr[4] = {pr[0], pr[1], pr[2], pr[3]};
        asm volatile("" : "+v"(opr[0]), "+v"(opr[1]), "+v"(opr[2]), "+v"(opr[3]));
#pragma unroll
        for (int c = 0; c < 5; ++c) { u32x2 w; w.x = pk2(C[c][0], C[c][1]); w.y = pk2(C[c][2], C[c][3]); *(LAS u32x2*)(Cb + (16 * c + fr) * 72 + 16 * hw + 4 * fq) = w; }
        *(LAS u32x4*)(Qs + t_ld * 72 + cg * 16) = rq[0]; *(LAS u32x4*)(Qs + t_ld * 72 + cg * 16 + 8) = rq[1];
        *(LAS u32x4*)(Ks + t_ld * 72 + cg * 16) = rk[0]; *(LAS u32x4*)(Ks + t_ld * 72 + cg * 16 + 8) = rk[1];
        { const unsigned vw[8] = {rv[0].x, rv[0].y, rv[0].z, rv[0].w, rv[1].x, rv[1].y, rv[1].z, rv[1].w};
#pragma unroll
            for (int e = 0; e < 8; ++e) { Vt[(cg * 16 + 2 * e) * 72 + t_ld] = (bf16_t)(vw[e] & 0xffffu); Vt[(cg * 16 + 2 * e + 1) * 72 + t_ld] = (bf16_t)(vw[e] >> 16); } }
        if (hw == 0) {
            const float i2 = rig * LOG2E, lf2 = -lg2(1.f + ex2(-rfg * LOG2E));
            float b2 = lf2;
#pragma unroll
            for (int o = 1; o < 64; o <<= 1) { const float y = __shfl_up(b2, o); if (lane >= o) b2 += y; }
            const float g2 = i2 - b2; float pm = g2;
#pragma unroll
            for (int o = 1; o < 64; o <<= 1) { const float y = __shfl_up(pm, o); if (lane >= o) pm = fmaxf(pm, y); }
            const float m2 = fmaxf(pm, m2prev);
            const float m63 = __shfl(m2, 63), b63 = __shfl(b2, 63);
            G2[lane] = g2; M2[lane] = m2; WI[lane] = ex2(m2prev - m2); EM[lane] = ex2(fminf(-(b2 + m2), ECLAMP)); WS[lane] = ex2(g2 - m63);
            if (lane == 0) MISC[0] = ex2(m2prev - m63);
            m2prev = b63 + m63;
        }
        LBAR();
        { const float ws = WS[t_ld]; const unsigned kw[8] = {rk[0].x, rk[0].y, rk[0].z, rk[0].w, rk[1].x, rk[1].y, rk[1].z, rk[1].w};
#pragma unroll
            for (int e = 0; e < 8; ++e) { const unsigned p = pk2(bflo(kw[e]) * ws, bfhi(kw[e]) * ws); KhT[(cg * 16 + 2 * e) * 72 + t_ld] = (bf16_t)(p & 0xffffu); KhT[(cg * 16 + 2 * e + 1) * 72 + t_ld] = (bf16_t)(p >> 16); } }
        LBAR();
        if (j + 1 < NSTEP) { chunk_geom(j + 1, b, dir, rowbase, pos0, slen, first, isx); pmode = (A.last && !isx) ? 0 : pre_mode(first, j + 1); jnx = j + 1; ML_LOAD(); }
        const int t = 16 * hw + fr; const float mt = M2[t];
#pragma unroll
        for (int st = 0; st < 4; ++st) {
            f32x4 acc = (f32x4){0.f, 0.f, 0.f, 0.f};
            if (st <= hw) {
#pragma unroll
                for (int kk = 0; kk < 2; ++kk) acc = mfma16(ldfrag(Ks, 72, 16 * st, 32 * kk, lane), ldfrag(Qs, 72, 16 * hw, 32 * kk, lane), acc);
#pragma unroll
                for (int i = 0; i < 4; ++i) { const float wgt = ex2(G2[16 * st + 4 * fq + i] - mt); acc[i] = (st < hw || 4 * fq + i <= fr) ? acc[i] * wgt : 0.f; }
            }
            u32x2 w; w.x = pk2(acc[0], acc[1]); w.y = pk2(acc[2], acc[3]);
            *(LAS u32x2*)(Sc + (16 * hw + fr) * 72 + 16 * st + 4 * fq) = w;
        }
        {
            f32x4 nu[5]; const float wi = WI[t];
#pragma unroll
            for (int c = 0; c < 5; ++c) { f32x4 a1 = (f32x4){0.f, 0.f, 0.f, 0.f}, a2 = (f32x4){0.f, 0.f, 0.f, 0.f};
#pragma unroll
                for (int ks = 0; ks < 2; ++ks) a1 = mfma16(ldfrag(Vt, 72, 16 * c, 32 * ks, lane), ldfrag(Sc, 72, 16 * hw, 32 * ks, lane), a1);
#pragma unroll
                for (int kk = 0; kk < 2; ++kk) a2 = mfma16(ldfrag(Cb, 72, 16 * c, 32 * kk, lane), ldfrag(Qs, 72, 16 * hw, 32 * kk, lane), a2);
                nu[c] = a1 + a2 * wi; }
            const float den = __shfl(nu[4][0], fr);
            const float inv = rcpf_(fmaxf(fabsf(den), EM[t]));
            bf16_t* op = opb + (size_t)(orow + (dir ? 63 - t : t)) * 1024;
            if (owrite) {
#pragma unroll
                for (int c = 0; c < 4; ++c) out_put4(op + 16 * c, nu[c] * inv, omode, opr[c]); }
        }
        { const float carry = MISC[0];
#pragma unroll
            for (int c = 0; c < 5; ++c) { f32x4 d = C[c] * carry;
#pragma unroll
                for (int ks = 0; ks < 2; ++ks) d = mfma16(ldfrag(KhT, 72, 16 * hw, 32 * ks, lane), ldfrag(Vt, 72, 16 * c, 32 * ks, lane), d);
                C[c] = d; } }
        if (j == 1 || j == 35) asm volatile("s_waitcnt vmcnt(0)" ::: "memory");
        LBAR();
    }
#undef ML_LOAD
}

DI void scan_lru(const ScanArgs& A, LAS unsigned char* lds, int unit) {
    const int tid = otid(), dir = tid >> 8, ht = tid & 255, hw = ht >> 6, lane = tid & 63, fr = lane & 15, fq = lane >> 4;
    const int b = 0, nbk = unit & 7;
    LAS unsigned char* L = lds + dir * 76288;
    LAS bf16_t* WG = (LAS bf16_t*)L;
    LAS bf16_t* XC = WG + 2 * 64 * 72;
    LAS bf16_t* XR = XC + 64 * 72;
    LAS float* AA = (LAS float*)(XR + 68 * 64);
    LAS float* UU = AA + 64 * 68;
    LAS float* CW = UU + 64 * 68;
    LAS float* CB = CW + 256; LAS float* BRr = CB + 64; LAS float* BIi = BRr + 64; LAS float* C8 = BIi + 64; LAS float* SEGA = C8 + 64; LAS float* SEGH = SEGA + 256; LAS float* HST = SEGH + 256;
    for (int i = ht; i < 2 * 64 * 64; i += 256) { const int g = i >> 12, d = (i >> 6) & 63, e = i & 63;
        WG[(g * 64 + e) * 72 + d] = (bf16_t)(pk2(A.gw[(((size_t)(dir * 2 + g) * 8 + nbk) * 64 + d) * 64 + e], 0.f) & 0xffffu); }
    for (int i = ht; i < 256; i += 256) CW[i] = A.convw[(i >> 6) * 512 + nbk * 64 + (i & 63)];
    if (ht < 128) HST[ht] = 0.f;
    if (ht < 64) { CB[ht] = A.convb[nbk * 64 + ht]; BRr[ht] = A.gb[(dir * 2 + 0) * 512 + nbk * 64 + ht]; BIi[ht] = A.gb[(dir * 2 + 1) * 512 + nbk * 64 + ht];
        const float lm = A.lam[dir * 512 + nbk * 64 + ht]; const float sp = (lm > 15.f) ? __expf(-lm) : log1pf(__expf(-lm)); C8[ht] = -8.f * sp * LOG2E; }
    const bf16_t* Px = A.P + 3072 + nbk * 64;
    u32x4 rx[3]; unsigned long long pr[4] = {0ull, 0ull, 0ull, 0ull}; int pmode = 0;
    bf16_t* const opb = A.SL + nbk * 64 + (ht & 3) * 16;
    int rowbase, pos0, slen; bool first, isx;
    chunk_geom(0, b, dir, rowbase, pos0, slen, first, isx);
#define LRU_LOAD() do { _Pragma("unroll") for (int q = 0; q < 3; ++q) { const int id = ht + 256 * q, i = id >> 3, c8 = id & 7; const int pos = pos0 - 2 + i; \
        rx[q] = (u32x4){0u, 0u, 0u, 0u}; if (id < 544 && pos >= 0 && pos < slen) rx[q] = *(const u32x4*)(Px + (size_t)(rowbase - 2 + i) * NP + c8 * 8); } \
        if (pmode == 1 && !late_pre(jnx)) { const int t = ht >> 2; const bf16_t* op = opb + (size_t)(rowbase + (dir ? 63 - t : t)) * 512; _Pragma("unroll") for (int q = 0; q < 4; ++q) pr[q] = ld8_coh(op + 4 * q); } } while (0)
    int jnx = 0;
    pmode = (A.last && !isx) ? 0 : pre_mode(first, 0);
    LRU_LOAD();
    LBAR();
    for (int j = 0; j < NSTEP; ++j) {
        const int orow = rowbase; const bool owrite = !(A.last && !isx); const int omode = pmode;
        if (late_pre(j) && pmode == 1) { const int t = ht >> 2; const bf16_t* op = opb + (size_t)(rowbase + (dir ? 63 - t : t)) * 512; _Pragma("unroll") for (int q = 0; q < 4; ++q) pr[q] = ld8_coh(op + 4 * q); }
        unsigned long long opr[4] = {pr[0], pr[1], pr[2], pr[3]};
        asm volatile("" : "+v"(opr[0]), "+v"(opr[1]), "+v"(opr[2]), "+v"(opr[3]));
#pragma unroll
        for (int q = 0; q < 3; ++q) { const int id = ht + 256 * q; if (id < 544) *(LAS u32x4*)(XR + (id >> 3) * 64 + (id & 7) * 8) = rx[q]; }
        LBAR();
        if (j + 1 < NSTEP) { chunk_geom(j + 1, b, dir, rowbase, pos0, slen, first, isx); pmode = (A.last && !isx) ? 0 : pre_mode(first, j + 1); jnx = j + 1; LRU_LOAD(); }
        { const int t = ht >> 2, d0 = (ht & 3) * 16, i0 = dir ? 63 - t : t; float xc[16];
#pragma unroll
            for (int e4 = 0; e4 < 4; ++e4) { const f32x4 c4 = *(const LAS f32x4*)(CB + d0 + 4 * e4); xc[4 * e4] = c4[0]; xc[4 * e4 + 1] = c4[1]; xc[4 * e4 + 2] = c4[2]; xc[4 * e4 + 3] = c4[3]; }
#pragma unroll
            for (int tap = 0; tap < 4; ++tap) { const u32x4 a0 = *(const LAS u32x4*)(XR + (i0 + tap) * 64 + d0), a1 = *(const LAS u32x4*)(XR + (i0 + tap) * 64 + d0 + 8);
                const unsigned ww[8] = {a0.x, a0.y, a0.z, a0.w, a1.x, a1.y, a1.z, a1.w};
#pragma unroll
                for (int e4 = 0; e4 < 4; ++e4) { const f32x4 w4 = *(const LAS f32x4*)(CW + tap * 64 + d0 + 4 * e4);
                    xc[4 * e4] += w4[0] * bflo(ww[2 * e4]); xc[4 * e4 + 1] += w4[1] * bfhi(ww[2 * e4]); xc[4 * e4 + 2] += w4[2] * bflo(ww[2 * e4 + 1]); xc[4 * e4 + 3] += w4[3] * bfhi(ww[2 * e4 + 1]); } }
            u32x4 w0, w1; w0.x = pk2(xc[0], xc[1]); w0.y = pk2(xc[2], xc[3]); w0.z = pk2(xc[4], xc[5]); w0.w = pk2(xc[6], xc[7]); w1.x = pk2(xc[8], xc[9]); w1.y = pk2(xc[10], xc[11]); w1.z = pk2(xc[12], xc[13]); w1.w = pk2(xc[14], xc[15]);
            *(LAS u32x4*)(XC + t * 72 + d0) = w0; *(LAS u32x4*)(XC + t * 72 + d0 + 8) = w1; }
        LBAR();
        { const int t = 16 * hw + fr;
#pragma unroll
            for (int et = 0; et < 4; ++et) { f32x4 ar = (f32x4){0.f, 0.f, 0.f, 0.f}, ai = (f32x4){0.f, 0.f, 0.f, 0.f};
#pragma unroll
                for (int kk = 0; kk < 2; ++kk) { const bf16x8 xb = ldfrag(XC, 72, 16 * hw, 32 * kk, lane);
                    ar = mfma16(ldfrag(WG, 72, 16 * et, 32 * kk, lane), xb, ar); ai = mfma16(ldfrag(WG + 64 * 72, 72, 16 * et, 32 * kk, lane), xb, ai); }
                const int e0 = 16 * et + 4 * fq; f32x4 av, uv;
                const u32x2 xw = *(const LAS u32x2*)(XC + t * 72 + e0); const float xv[4] = {bflo(xw.x), bfhi(xw.x), bflo(xw.y), bfhi(xw.y)};
                const f32x4 br4 = *(const LAS f32x4*)(BRr + e0), bi4 = *(const LAS f32x4*)(BIi + e0), c84 = *(const LAS f32x4*)(C8 + e0);
#pragma unroll
                for (int i = 0; i < 4; ++i) { const float r = ar[i] + br4[i], g = ai[i] + bi4[i];
                    const float pa = 1.f + ex2(-LOG2E * r), pb = 1.f + ex2(-LOG2E * g);
                    const float pm = fminf(pa * pb, 3.0e38f), rinv = rcpf_(pm);
                    const float sr = fminf(pb, 3.0e38f) * rinv, sg = fminf(pa, 3.0e38f) * rinv;
                    const float al = ex2(c84[i] * sr);
                    av[i] = al; uv[i] = __builtin_amdgcn_sqrtf(fmaxf(1.f - al * al, 0.f)) * sg * xv[i]; }
                *(LAS f32x4*)(AA + t * 68 + e0) = av; *(LAS f32x4*)(UU + t * 68 + e0) = uv; } }
        LBAR();
        {
            float hv[16], av[16]; float ap = 1.f, hl = 0.f;
#pragma unroll
            for (int i = 0; i < 16; ++i) { const float al = AA[(16 * hw + i) * 68 + lane], uu = UU[(16 * hw + i) * 68 + lane]; hl = al * hl + uu; ap *= al; hv[i] = hl; av[i] = ap; }
            SEGA[hw * 64 + lane] = ap; SEGH[hw * 64 + lane] = hl;
            LBAR();
            float carry = HST[(j & 1) * 64 + lane];
            for (int sg = 0; sg < hw; ++sg) carry = SEGA[sg * 64 + lane] * carry + SEGH[sg * 64 + lane];
#pragma unroll
            for (int i = 0; i < 16; ++i) UU[(16 * hw + i) * 68 + lane] = hv[i] + av[i] * carry;
            if (hw == 3) HST[((j + 1) & 1) * 64 + lane] = hv[15] + av[15] * carry;
        }
        LBAR();
        if (owrite) { const int t = ht >> 2, d0 = (ht & 3) * 16; bf16_t* op = opb + (size_t)(orow + (dir ? 63 - t : t)) * 512;
#pragma unroll
            for (int q = 0; q < 4; ++q) out_put4(op + 4 * q, *(const LAS f32x4*)(UU + t * 68 + d0 + 4 * q), omode, opr[q]); }
        if (j == 1 || j == 35) asm volatile("s_waitcnt vmcnt(0)" ::: "memory");
    }
    LBAR();
#undef LRU_LOAD
}
DI void phase_scan(const ScanArgs& A, LAS unsigned char* lds, int gr, int gs) {
    for (int u = gr; u < 32; u += gs) {
#ifndef NO_HG
        if (u < 16) scan_hgrn2(A, lds, u);
#ifdef DBL_HG
        if (u < 16) { __syncthreads(); scan_hgrn2(A, lds, u); }
#endif
#endif
#ifndef NO_ML
        if (u >= 16 && u < 24) scan_mlstm(A, lds, u - 16);
#ifdef DBL_ML
        if (u >= 16 && u < 24) { __syncthreads(); scan_mlstm(A, lds, u - 16); }
#endif
#endif
#ifndef NO_LRU
        if (u >= 24) scan_lru(A, lds, u - 24);
#ifdef DBL_LRU
        if (u >= 24) { __syncthreads(); scan_lru(A, lds, u - 24); }
#endif
#endif
        __syncthreads();
    }
}


#ifdef PROBE_CS
DI void cksum(const void* p, size_t bytes, unsigned long long* dst, int gr, int gs) {
    const unsigned* w = (const unsigned*)p; const size_t n = bytes / 4; unsigned long long acc = 0;
    const int tid = otid();
    for (unsigned i = (unsigned)gr * 512u + (unsigned)tid; i < (unsigned)n; i += (unsigned)gs * 512u) acc += (unsigned long long)w[i] * (unsigned long long)((i & 1023u) + 1u);
#pragma unroll
    for (int o = 1; o < 64; o <<= 1) acc += __shfl_xor(acc, o);
    if ((tid & 63) == 0) atomicAdd(dst, acc);
}
__global__ void cs_compare(const unsigned long long* CS, float* out, int n) {
    const size_t gt = (size_t)blockIdx.x * blockDim.x + threadIdx.x, gs = (size_t)gridDim.x * blockDim.x;
    int code = 0;
    for (int p = 63; p >= 0; --p) if (CS[p] != CS[64 + p]) code = p + 1;
    for (size_t i = gt; i < (size_t)n; i += gs) out[i] = (i == 0) ? 1000.f * (float)code : 0.f;
}
#define CK(idx, ptr, bytes) do { if (l == PROBE_CS - 1) cksum(ptr, bytes, CSA + a.run * 64 + (idx), gr, gs); } while (0)
#else
#define CK(idx, ptr, bytes) do { } while (0)
#endif
DI unsigned xcc_id() { return (unsigned)__builtin_amdgcn_s_getreg((3 << 11) | 20) & 0xFu; }
DI void xsync(unsigned* bar, unsigned gs, unsigned& epoch) {
    asm volatile("s_waitcnt vmcnt(0) lgkmcnt(0)" ::: "memory");
    __syncthreads();
    epoch = __builtin_amdgcn_readfirstlane(epoch + 1u);
    if (threadIdx.x == 0) {
        const unsigned old = __hip_atomic_fetch_add(bar, 1u, __ATOMIC_RELAXED, __HIP_MEMORY_SCOPE_AGENT);
        if (old + 1u == epoch * gs) __hip_atomic_store(bar + 64, epoch, __ATOMIC_RELAXED, __HIP_MEMORY_SCOPE_AGENT);
        else while (__hip_atomic_load(bar + 64, __ATOMIC_RELAXED, __HIP_MEMORY_SCOPE_AGENT) < epoch) __builtin_amdgcn_s_sleep(1);
    }
    if (threadIdx.x < 64) {
        __builtin_amdgcn_fence(__ATOMIC_ACQUIRE, "agent");
        asm volatile("s_waitcnt vmcnt(0)" ::: "memory");
    }
    __syncthreads();
}
__global__ void __launch_bounds__(512, 2) fwd_kernel(KArgs a) {
    extern __shared__ __attribute__((aligned(16))) unsigned char lds_raw[];
    LAS unsigned char* lds = (LAS unsigned char*)lds_raw;
    cg::grid_group grid = cg::this_grid();
#define GSYNC() do { asm volatile("s_waitcnt vmcnt(0) lgkmcnt(0)" ::: "memory"); grid.sync(); if (threadIdx.x < 64) { __builtin_amdgcn_fence(__ATOMIC_ACQUIRE, "agent"); asm volatile("s_waitcnt vmcnt(0)" ::: "memory"); } __syncthreads(); } while (0)
    unsigned char* ws = a.ws;
    float* MOD = (float*)(ws + WS_MOD); float* BIASA = (float*)(ws + WS_BIAS); float* LB = (float*)(ws + WS_LB); float* MLG = (float*)(ws + WS_MLG);
    unsigned* CTL = (unsigned*)(ws + WS_CTL);
    unsigned char* wsw = ws + WS_W; float* CTXW = (float*)(ws + WS_CTXW);
    bf16_t* AS = (bf16_t*)(ws + WS_AS); bf16_t* SL = (bf16_t*)(ws + WS_SL); bf16_t* BR = (bf16_t*)(ws + WS_BR); bf16_t* P = (bf16_t*)(ws + WS_P);

    volatile LAS unsigned* GI = (volatile LAS unsigned*)(lds + LDS_BYTES - 64);
    const unsigned myx = xcc_id();
    if (threadIdx.x == 0) GI[0] = __hip_atomic_fetch_add(CTL + 64 * myx + a.run * 8192, 1u, __ATOMIC_RELAXED, __HIP_MEMORY_SCOPE_AGENT);
    phase_mod(a, lds, MOD, LB);
    phase_conv(a, lds, 0, wsw, BIASA);
    GSYNC();
    if (threadIdx.x == 0) { unsigned ng = 0, g = 0, gs = 1;
        for (unsigned x = 0; x < 16; ++x) { const unsigned c = __hip_atomic_load(CTL + 64 * x + a.run * 8192, __ATOMIC_RELAXED, __HIP_MEMORY_SCOPE_AGENT); if (c) { if (x == myx) { g = ng; gs = c; } ++ng; } }
        GI[1] = g; GI[2] = gs; GI[3] = ng; }
    __syncthreads();
    const int gr = __builtin_amdgcn_readfirstlane((int)GI[0]), gg = __builtin_amdgcn_readfirstlane((int)GI[1]), gs = __builtin_amdgcn_readfirstlane((int)GI[2]), ng = __builtin_amdgcn_readfirstlane((int)GI[3]);
    unsigned* bar = CTL + 2048 + 128 * gg + a.run * 4096; unsigned epoch = 0;
    unsigned long long* CSA = (unsigned long long*)(ws + WS_LB + 32768); (void)CSA;
#define XSYNC() xsync(bar, (unsigned)gs, epoch)
    constexpr int RB = 4352;

    for (int l = 0; l < DEPTH; ++l) {
        const bool last = (l == DEPTH - 1); const int cm = l & 1;
        const float* xs = (l == 0) ? a.in[0] : a.out; const float* cs = (l == 0) ? a.in[2] : CTXW;
        const float* modl = MOD + (size_t)l * 9 * 6144; const float* BIAS = BIASA + l * NW1;
        const int Mall = RB, Mx = last ? 4096 : RB;
        unsigned char* wl = (l & 1) ? ws + WS_W2 : wsw;
        const bf16_t* W1 = (const bf16_t*)(wl + W_W1); const bf16_t* WGt = W1 + (size_t)N1 * 1024; const bf16_t* WBR = (const bf16_t*)(wl + W_BR);
        const bf16_t* WO = (const bf16_t*)(wl + W_O); const bf16_t* WFI = (const bf16_t*)(wl + W_FI); const bf16_t* WFO = (const bf16_t*)(wl + W_FO);
        for (int b = gg; b < NB; b += ng) phase_norm(xs, cs, a.in[6] + l * 1024, modl, 0, 1, cm, AS + (size_t)b * RB * 1024, Mall, b, gr, gs);
        if (l > 0) GSYNC(); else XSYNC();
        for (int b = gg; b < NB; b += ng) { CK(3, AS + (size_t)b * RB * 1024, (size_t)RB * 2048); }
        for (int b = gg; b < NB; b += ng) { Epi1 E{P + (size_t)b * RB * NP, BR + (size_t)b * RB * 1536, MLG + (size_t)b * RB * 16, BIAS, LB + l * 1024}; run_gemm(lds, AS + (size_t)b * RB * 1024, W1, Mall, N1, 1024, E, gr, gs); }
        XSYNC();
        for (int b = gg; b < NB; b += ng) { CK(4, P + (size_t)b * RB * NP, (size_t)RB * NP * 2); CK(5, BR + (size_t)b * RB * 1536, (size_t)RB * 1024); CK(6, MLG + (size_t)b * RB * 16, (size_t)RB * 64); }
        for (int b = gg; b < NB; b += ng) { ScanArgs S{P + (size_t)b * RB * NP, MLG + (size_t)b * RB * 16, AS + (size_t)b * RB * 1024, SL + (size_t)b * RB * 512, a.in[12] + l * 4 * 512, a.in[13] + l * 512, a.in[14] + (size_t)l * 2 * 2 * 8 * 64 * 64, a.in[15] + l * 2 * 2 * 512, a.in[16] + l * 2 * 512, last ? 1 : 0};
            phase_scan(S, lds, gr, gs);
#ifdef DBL_SCAN
            phase_scan(S, lds, gr, gs);
#endif
            }
        XSYNC();
        for (int b = gg; b < NB; b += ng) { CK(7, AS + (size_t)b * RB * 1024, (size_t)RB * 2048); CK(8, SL + (size_t)b * RB * 512, (size_t)RB * 1024); }
        for (int b = gg; b < NB; b += ng) phase_fin(xs, cs, a.in[6] + l * 1024, modl, cm, AS + (size_t)b * RB * 1024, SL + (size_t)b * RB * 512, BR + (size_t)b * RB * 1536, a.in[10] + l * 512, a.in[11] + l * 512, Mx, b, gr, gs);
        XSYNC();
        for (int b = gg; b < NB; b += ng) { CK(9, AS + (size_t)b * RB * 1024, (size_t)RB * 2048); CK(10, BR + (size_t)b * RB * 1536, (size_t)RB * 1024); }
        for (int b = gg; b < NB; b += ng) { Epi2 E{P + (size_t)b * RB * NP, BIAS + N1}; run_gemm(lds, AS + (size_t)b * RB * 1024, WGt, Mx, NG, 1024, E, gr, gs); }
        XSYNC();
        for (int b = gg; b < NB; b += ng) { CK(11, P + (size_t)b * RB * NP, (size_t)RB * NG * 2); }
        for (int b = gg; b < NB; b += ng) { Epi3 E{P + (size_t)b * RB * NP, AS + (size_t)b * RB * 1024}; run_gemm(lds, BR + (size_t)b * RB * 1536, WBR, Mx, 1024, 1536, E, gr, gs); }
        XSYNC();
        for (int b = gg; b < NB; b += ng) { CK(12, AS + (size_t)b * RB * 1024, (size_t)RB * 2048); }
        for (int b = gg; b < NB; b += ng) { EpiRes E{xs, a.out, cs, CTXW, modl + 2 * 1024, cm, ((PROBE_MIX >> l) & 1) ? 0.f : 1.f, b}; run_gemm(lds, AS + (size_t)b * RB * 1024, WO, Mx, 1024, 1024, E, gr, gs); }
        XSYNC();
        for (int b = gg; b < NB; b += ng) { CK(13, a.out + (size_t)b * 4096 * 1024, (size_t)4096 * 4096); CK(14, CTXW + (size_t)b * 256 * 1024, (size_t)256 * 4096); }
        for (int b = gg; b < NB; b += ng) phase_norm(a.out, CTXW, a.in[19] + l * 1024, modl, 3, 4, 0, AS + (size_t)b * RB * 1024, Mx, b, gr, gs);
#ifdef DBL_P5
        for (int b = gg; b < NB; b += ng) phase_norm(a.out, CTXW, a.in[19] + l * 1024, modl, 3, 4, 0, AS + (size_t)b * RB * 1024, Mx, b, gr, gs);
#endif
        XSYNC();
        for (int b = gg; b < NB; b += ng) { CK(15, AS + (size_t)b * RB * 1024, (size_t)RB * 2048); }
        for (int b = gg; b < NB; b += ng) { Epi5 E{P + (size_t)b * RB * NP}; run_gemm(lds, AS + (size_t)b * RB * 1024, WFI, Mx, 2 * FF, 1024, E, gr, gs); }
#ifdef DBL_G5
        for (int b = gg; b < NB; b += ng) { Epi5 E{P + (size_t)b * RB * NP}; run_gemm(lds, AS + (size_t)b * RB * 1024, WFI, Mx, 2 * FF, 1024, E, gr, gs); }
#endif
        XSYNC();
        for (int b = gg; b < NB; b += ng) { CK(16, P + (size_t)b * RB * NP, (size_t)RB * FF * 2); }
        for (int b = gg; b < NB; b += ng) { EpiRes E{a.out, a.out, CTXW, CTXW, modl + 5 * 1024, 0, ((PROBE_FFN >> l) & 1) ? 0.f : 1.f, b}; run_gemm(lds, P + (size_t)b * RB * NP, WFO, Mx, 1024, FF, E, gr, gs); }
        if (!last) phase_conv_q(a, lds, l + 1, ((l + 1) & 1) ? ws + WS_W2 : wsw, BIASA, CTL + 12288 + 64 * l);
        XSYNC();
        for (int b = gg; b < NB; b += ng) { CK(17, a.out + (size_t)b * 4096 * 1024, (size_t)4096 * 4096); }
    }
    for (int b = gg; b < NB; b += ng) phase_final(a.out + (size_t)b * 4096 * 1024, a.in[22], gr, gs);
}

extern "C" void kernel_launch(void* const* d_in, const int* in_sizes, int n_in, void* d_out, int out_size, void* d_ws, size_t ws_size, hipStream_t stream) {
    static int grid = 0;
    if (grid == 0) {
        if (n_in != 23 || out_size != MX * D || ws_size < WS_END) { fprintf(stderr, "kernel_launch: unexpected problem (n_in %d out %d ws %zu need %zu)\n", n_in, out_size, ws_size, (size_t)WS_END); grid = -1; return; }
        int dev = 0, cus = 0, per_cu = 0;
        if (hipGetDevice(&dev) != hipSuccess || hipDeviceGetAttribute(&cus, hipDeviceAttributeMultiprocessorCount, dev) != hipSuccess) { grid = -1; return; }
        if (hipFuncSetAttribute((const void*)fwd_kernel, hipFuncAttributeMaxDynamicSharedMemorySize, LDS_BYTES) != hipSuccess) { fprintf(stderr, "kernel_launch: hipFuncSetAttribute failed\n"); grid = -1; return; }
        if (hipOccupancyMaxActiveBlocksPerMultiprocessor(&per_cu, (const void*)fwd_kernel, 512, LDS_BYTES) != hipSuccess || per_cu < 1) { fprintf(stderr, "kernel_launch: occupancy query says %d\n", per_cu); per_cu = 1; }
        (void)hipGetLastError();
        grid = cus * per_cu;
        if (grid > 256) grid = 256;
    }
    if (grid < 0) return;
    (void)hipMemsetAsync((char*)d_ws + WS_CTL, 0, 65536, stream);
    KArgs a{};
    for (int i = 0; i < 23; ++i) a.in[i] = (const float*)d_in[i];
    a.out = (float*)d_out; a.ws = (unsigned char*)d_ws;
    void* args[] = {&a};
#ifdef PROBE_CS
    (void)hipMemsetAsync((char*)d_ws + WS_LB + 32768, 0, 1024, stream);
    (void)hipLaunchCooperativeKernel((void*)fwd_kernel, dim3(grid), dim3(512), args, LDS_BYTES, stream);
    a.run = 1;
#endif
    hipError_t e = hipLaunchCooperativeKernel((void*)fwd_kernel, dim3(grid), dim3(512), args, LDS_BYTES, stream);
#ifdef PROBE_CS
    hipLaunchKernelGGL(cs_compare, dim3(1024), dim3(256), 0, stream, (const unsigned long long*)((char*)d_ws + WS_LB + 32768), (float*)d_out, out_size);
#endif
    if (e != hipSuccess) fprintf(stderr, "kernel_launch: cooperative launch failed: %s (grid %d)\n", hipGetErrorString(e), grid);
}
```

```cpp
#include <hip/hip_runtime.h>
#include <hip/hip_cooperative_groups.h>
#include <cstdio>
#include <cstdint>
namespace cg = cooperative_groups;
#ifndef PROBE_MIX
#define PROBE_MIX 0
#endif
#ifndef PROBE_FFN
#define PROBE_FFN 0
#endif
#ifndef PROBE_BR
#define PROBE_BR 0
#endif
#define PG8_ALIGN_V true
#define PG8_SP2_V true
namespace pg8 {
#define PG8_LAS __attribute__((address_space(3)))
typedef unsigned short bf16_t;
typedef short bf16x8 __attribute__((ext_vector_type(8)));
typedef float f32x4 __attribute__((ext_vector_type(4)));
typedef unsigned u32x4 __attribute__((ext_vector_type(4)));
constexpr int BM = 256, BK = 64, HALF = 128, HTB = HALF * BK * 2  , STAGE_BYTES = 8 * HTB, NXCD = 8, WGM = 8;

__host__ __device__ __forceinline__ int lds_byte(int r, int c) { const int st = (r >> 4) * 2 + (c >> 5), rr = r & 15, cc = c & 31, ob = rr * 64 + cc * 2; return st * 1024 + (ob ^ (((ob >> 9) & 1) << 5)); }
__host__ __device__ __forceinline__ void stage_rc(int b, int& R, int& C) { const int st = b / 1024, sb = b % 1024, swz = sb ^ (((sb >> 9) & 1) << 5); R = (st >> 1) * 16 + swz / 64; C = (st & 1) * 32 + (swz % 64) / 2; }
__host__ __device__ __forceinline__ int perm32(int rho) { const int n = rho >> 4, i = rho & 15; return 8 * (i >> 2) + 4 * n + (i & 3); }

struct Unit { int pm, pn; };
struct Gemm { const bf16_t* A; const bf16_t* Bt; int M, N, K; };

struct StaticOrder {
    int nM, nN, nwg, G, c;
    __host__ __device__ void init(int M, int N, int G_, int c_) { nM = M / BM; nN = N / BM; nwg = nM * nN; G = G_; c = c_; }
    __host__ __device__ bool next(int i, Unit& u) const {
        const long L = (long)i * G + c; if (L >= nwg) return false;
        int wgid = (int)L; { const int q = nwg / NXCD, r = nwg % NXCD, xcd = wgid % NXCD, off = wgid / NXCD; wgid = (xcd < r ? xcd * (q + 1) : r * (q + 1) + (xcd - r) * q) + off; }
        const int nig = WGM * nN, gid = wgid / nig, fm = gid * WGM, gsz = (nM - fm) < WGM ? (nM - fm) : WGM;
        u.pm = fm + ((wgid % nig) % gsz); u.pn = (wgid % nig) / gsz; return true;
    }
    __device__ __forceinline__ void a_ready(const Unit&) const {}
    __device__ __forceinline__ void done(const Unit&) const {}
};
__device__ __forceinline__ unsigned cvt_pk_bf16(float lo, float hi) { unsigned r; asm volatile("v_cvt_pk_bf16_f32 %0, %1, %2" : "=v"(r) : "v"(lo), "v"(hi)); return r; }
typedef float f32x2 __attribute__((ext_vector_type(2)));
template <class Epi, class Sched, bool ALIGN_EPI = false, bool SP2 = false>
__device__ __forceinline__ void gemm_phase(PG8_LAS unsigned char* lds, const Gemm g, const Sched& S, const Epi& E) {
    int tid_ = threadIdx.x; asm volatile("" : "+v"(tid_)); const int tid = tid_, wid = __builtin_amdgcn_readfirstlane(tid >> 6), lane = tid & 63, wr = wid >> 2, wc = wid & 3, fr = lane & 15, fq = lane >> 4;
    const int K = g.K, nt = K / BK;
    unsigned voffA[2], voffB[2];
#pragma unroll
    for (int i = 0; i < 2; ++i) { int R, C; stage_rc(tid * 16 + i * 8192, R, C); const int Rb = Epi::PERM ? ((R & ~31) + perm32(R & 31)) : R;
        voffA[i] = (unsigned)(R * K + C) * 2u; voffB[i] = (unsigned)(Rb * K + C) * 2u; }
    const size_t kstep = (size_t)(BK * 2);
    const size_t hstep = (size_t)HALF * K * 2;
    const size_t tstep = 2 * hstep;
    const unsigned ldsw = (unsigned)wid * 1024u;
    const int aoff = lds_byte(wr * 64 + fr, fq * 8), boff = lds_byte(wc * 32 + fr, fq * 8);
#define PG8_SA(b, h) (((b) * 2 + (h)) * HTB)
#define PG8_SB(b, h) ((4 + (b) * 2 + (h)) * HTB)
#define PG8_STAGE(bufoff, gbase, voff) do { _Pragma("unroll") for (int _i = 0; _i < 2; ++_i) \
        __builtin_amdgcn_global_load_lds((const unsigned*)((const char*)(gbase) + (voff)[_i]), (PG8_LAS unsigned*)(lds + (bufoff) + ldsw + _i * 8192), 16, 0, 0); } while (0)
#define PG8_LDA(dst, b, h) do { _Pragma("unroll") for (int m = 0; m < 4; ++m) _Pragma("unroll") for (int k = 0; k < 2; ++k) dst[m][k] = *(const PG8_LAS bf16x8*)(lds + PG8_SA(b, h) + aoff + m * 2048 + k * 1024); } while (0)
#define PG8_LDB(dst, b, h) do { _Pragma("unroll") for (int n = 0; n < 2; ++n) _Pragma("unroll") for (int k = 0; k < 2; ++k) dst[n][k] = *(const PG8_LAS bf16x8*)(lds + PG8_SB(b, h) + boff + n * 2048 + k * 1024); } while (0)
#define PG8_MMA(ai, bj, At, Bt) do { __builtin_amdgcn_s_setprio(1); _Pragma("unroll") for (int m = 0; m < 4; ++m) _Pragma("unroll") for (int n = 0; n < 2; ++n) _Pragma("unroll") for (int k = 0; k < 2; ++k) \
        acc[ai][bj][m][n] = __builtin_amdgcn_mfma_f32_16x16x32_bf16(Bt[n][k], At[m][k], acc[ai][bj][m][n], 0, 0, 0); __builtin_amdgcn_s_setprio(0); } while (0)
#define PG8_WAIT_V(n) asm volatile("s_waitcnt vmcnt(" #n ")" ::: "memory")
#define PG8_WAIT_L(n) asm volatile("s_waitcnt lgkmcnt(" #n ")" ::: "memory")
#define PG8_BAR __builtin_amdgcn_s_barrier()
#define PG8_SCHED __builtin_amdgcn_sched_barrier(0)
    Unit cur, nxt; int ui = 0;
    if (!S.next(0, cur)) return;
    f32x4 acc[2][2][4][2];
#pragma unroll
    for (int a = 0; a < 2; ++a)
#pragma unroll
        for (int b = 0; b < 2; ++b)
#pragma unroll
            for (int m = 0; m < 4; ++m)
#pragma unroll
                for (int n = 0; n < 2; ++n) acc[a][b][m][n] = (f32x4){0.f, 0.f, 0.f, 0.f};
    bf16x8 At[4][2], B0[2][2], B1[2][2];
    const char* cA = (const char*)g.A + (size_t)cur.pm * tstep; const char* cB = (const char*)g.Bt + (size_t)cur.pn * tstep;
    S.a_ready(cur);
    if constexpr (SP2) {
        PG8_STAGE(PG8_SB(0, 0), cB, voffB); PG8_STAGE(PG8_SB(0, 1), cB + hstep, voffB); PG8_STAGE(PG8_SA(0, 0), cA, voffA); PG8_STAGE(PG8_SA(0, 1), cA + hstep, voffA);
        if (wr == 1) PG8_BAR;
        PG8_WAIT_V(2); PG8_BAR;
        PG8_STAGE(PG8_SB(1, 0), cB + kstep, voffB); PG8_STAGE(PG8_SA(1, 0), cA + kstep, voffA); PG8_STAGE(PG8_SB(1, 1), cB + hstep + kstep, voffB);
        PG8_WAIT_V(6); PG8_BAR;
    } else {
        PG8_STAGE(PG8_SB(0, 0), cB, voffB); PG8_STAGE(PG8_SA(0, 0), cA, voffA); PG8_STAGE(PG8_SB(0, 1), cB + hstep, voffB); PG8_STAGE(PG8_SA(0, 1), cA + hstep, voffA);
        if (wr == 1) PG8_BAR;
        PG8_WAIT_V(4); PG8_BAR;
        PG8_STAGE(PG8_SB(1, 0), cB + kstep, voffB); PG8_STAGE(PG8_SA(1, 0), cA + kstep, voffA); PG8_STAGE(PG8_SB(1, 1), cB + hstep + kstep, voffB);
        PG8_WAIT_V(6); PG8_BAR;
    }
    for (;;) {
        const bool has_next = S.next(ui + 1, nxt);
        const char* nA = has_next ? (const char*)g.A + (size_t)nxt.pm * tstep : cA; const char* nB = has_next ? (const char*)g.Bt + (size_t)nxt.pn * tstep : cB;
        for (int t = 0; t < nt; t += 2) {
            const bool last = (t == nt - 2);
            if constexpr (Epi::HAS_MID) { if (t == 8 || t == 16) E.mid(acc, cur, t >> 3, wr, wc, fr, fq); }
            const char* a1 = cA + (size_t)(t + 1) * kstep;
            const char* a2 = last ? nA : cA + (size_t)(t + 2) * kstep; const char* b2 = last ? nB : cB + (size_t)(t + 2) * kstep;
            const char* a3 = a2 + kstep; const char* b3 = b2 + kstep;
            if (last && has_next) S.a_ready(nxt);
            if constexpr (SP2) {
            PG8_LDB(B0, 0, 0); PG8_LDB(B1, 0, 1); PG8_SCHED; PG8_LDA(At, 0, 0); PG8_STAGE(PG8_SA(1, 1), a1 + hstep, voffA);
            PG8_WAIT_V(8); PG8_WAIT_L(0); PG8_BAR; PG8_MMA(0, 0, At, B0); PG8_MMA(0, 1, At, B1); PG8_BAR; PG8_SCHED;
            PG8_LDA(At, 0, 1); PG8_STAGE(PG8_SB(0, 0), b2, voffB); PG8_STAGE(PG8_SB(0, 1), b2 + hstep, voffB); PG8_STAGE(PG8_SA(0, 0), a2, voffA);
            PG8_WAIT_V(8); PG8_WAIT_L(0); PG8_BAR; PG8_MMA(1, 0, At, B0); PG8_MMA(1, 1, At, B1); PG8_BAR; PG8_SCHED;
            PG8_LDB(B0, 1, 0); PG8_LDB(B1, 1, 1); PG8_SCHED; PG8_LDA(At, 1, 0); PG8_STAGE(PG8_SA(0, 1), a2 + hstep, voffA);
            PG8_WAIT_V(8); PG8_WAIT_L(0); PG8_BAR; PG8_MMA(0, 0, At, B0); PG8_MMA(0, 1, At, B1); PG8_BAR; PG8_SCHED;
            PG8_LDA(At, 1, 1); PG8_STAGE(PG8_SB(1, 0), b3, voffB); PG8_STAGE(PG8_SB(1, 1), b3 + hstep, voffB); PG8_STAGE(PG8_SA(1, 0), a3, voffA);
            PG8_WAIT_V(8); PG8_WAIT_L(0); PG8_BAR; PG8_MMA(1, 0, At, B0); PG8_MMA(1, 1, At, B1); PG8_BAR; PG8_SCHED;
            } else {
            PG8_LDB(B0, 0, 0); PG8_SCHED; PG8_LDA(At, 0, 0); PG8_STAGE(PG8_SA(1, 1), a1 + hstep, voffA);
            PG8_WAIT_L(8); PG8_BAR; PG8_WAIT_L(0); PG8_MMA(0, 0, At, B0); PG8_BAR; PG8_SCHED;
            PG8_LDB(B1, 0, 1); PG8_STAGE(PG8_SB(0, 0), b2, voffB);
            PG8_BAR; PG8_WAIT_L(0); PG8_MMA(0, 1, At, B1); PG8_BAR;
            PG8_LDA(At, 0, 1); PG8_STAGE(PG8_SA(0, 0), a2, voffA);
            PG8_BAR; PG8_WAIT_L(0); PG8_MMA(1, 0, At, B0); PG8_BAR; PG8_SCHED;
            PG8_STAGE(PG8_SB(0, 1), b2 + hstep, voffB);
            PG8_WAIT_V(6); PG8_BAR; PG8_MMA(1, 1, At, B1); PG8_BAR;
            PG8_LDB(B0, 1, 0); PG8_SCHED; PG8_LDA(At, 1, 0); PG8_STAGE(PG8_SA(0, 1), a2 + hstep, voffA);
            PG8_WAIT_L(8); PG8_BAR; PG8_WAIT_L(0); PG8_MMA(0, 0, At, B0); PG8_BAR; PG8_SCHED;
            PG8_LDB(B1, 1, 1); PG8_STAGE(PG8_SB(1, 0), b3, voffB);
            PG8_BAR; PG8_WAIT_L(0); PG8_MMA(0, 1, At, B1); PG8_BAR;
            PG8_LDA(At, 1, 1); PG8_STAGE(PG8_SA(1, 0), a3, voffA);
            PG8_BAR; PG8_WAIT_L(0); PG8_MMA(1, 0, At, B0); PG8_BAR; PG8_SCHED;
            PG8_STAGE(PG8_SB(1, 1), b3 + hstep, voffB);
            PG8_WAIT_V(6); PG8_BAR; PG8_MMA(1, 1, At, B1); PG8_BAR;
            }
        }
        if constexpr (ALIGN_EPI) { if (wr == 0) PG8_BAR; }
        if constexpr (!Epi::AFTER_DRAIN) { E(acc, cur, wr, wc, fr, fq); S.done(cur); }
        if (!has_next) break;
#pragma unroll
        for (int a = 0; a < 2; ++a)
#pragma unroll
            for (int b = 0; b < 2; ++b)
#pragma unroll
                for (int m = 0; m < 4; ++m)
#pragma unroll
                    for (int n = 0; n < 2; ++n) acc[a][b][m][n] = (f32x4){0.f, 0.f, 0.f, 0.f};
        cur = nxt; cA = nA; cB = nB; ++ui;
        if constexpr (ALIGN_EPI) { if (wr == 1) PG8_BAR; }
    }
    PG8_WAIT_V(0);
    if constexpr (!ALIGN_EPI) { if (wr == 0) PG8_BAR; }
    PG8_BAR;
    if constexpr (Epi::AFTER_DRAIN) { E.fused(acc, cur, wr, wc, fr, fq, lds, wid, lane); S.done(cur); }
#undef PG8_SA
#undef PG8_SB
#undef PG8_STAGE
#undef PG8_LDA
#undef PG8_LDB
#undef PG8_MMA
#undef PG8_WAIT_V
#undef PG8_WAIT_L
#undef PG8_BAR
#undef PG8_SCHED
}
}

#define LAS __attribute__((address_space(3)))
#define DI __device__ __forceinline__
typedef unsigned short bf16_t;
typedef short bf16x8 __attribute__((ext_vector_type(8)));
typedef float f32x4 __attribute__((ext_vector_type(4)));
typedef unsigned u32x4 __attribute__((ext_vector_type(4)));
typedef unsigned u32x2 __attribute__((ext_vector_type(2)));

constexpr int D = 1024, NB = 8, SEQ = 4096, DEPTH = 4, CTXL = 256;
constexpr int MX = NB * SEQ, MC = NB * CTXL, MT = MX + MC;
constexpr int NIN = 8208, NP = 3584, N1 = 5376, NG = 3072, FF = 2816, NW1 = N1 + NG;
constexpr float EPS = 1e-6f;
constexpr float LOG2E = 1.4426950408889634f;
constexpr size_t MiB = 1u << 20;
constexpr size_t WS_MOD = 0;
constexpr size_t WS_BIAS = 1 * MiB;
constexpr size_t WS_CTL = 5 * MiB;
constexpr size_t WS_LB = 1 * MiB + 262144;
constexpr size_t WS_MLG = 2 * MiB;
constexpr size_t WS_W = 6 * MiB;
constexpr size_t W_W1 = 0, W_BR = (size_t)NW1 * 1024 * 2, W_O = W_BR + 3ull * 1024 * 512 * 2, W_FI = W_O + 1024ull * 1024 * 2, W_FO = W_FI + 5632ull * 1024 * 2, W_END = W_FO + 1024ull * 2816 * 2;
constexpr size_t WS_CTXW = 46 * MiB;
constexpr size_t WS_AS = 54 * MiB;
constexpr size_t WS_SL = 122 * MiB;
constexpr size_t WS_BR = 156 * MiB;
constexpr size_t WS_P = 258 * MiB;
constexpr size_t WS_W2 = 258 * MiB + (size_t)MT * NP * 2;
constexpr size_t WS_END = WS_W2 + 39845888;
static_assert(W_END <= 39845888, "weights");
constexpr int LDS_BYTES = 155648;

DI float ex2(float x) { return __builtin_amdgcn_exp2f(x); }
DI float lg2(float x) { return __builtin_amdgcn_logf(x); }
DI float rcpf_(float x) { return __builtin_amdgcn_rcpf(x); }
DI float sigm(float x) { return rcpf_(1.f + ex2(-LOG2E * x)); }
DI float silu_(float x) { return x * sigm(x); }
DI float gelu_t(float x) { const float u = 1.5957691216f * (x + 0.044715f * x * x * x); return x * sigm(u); }
typedef __bf16 bf2_t __attribute__((ext_vector_type(2)));
DI unsigned pk2(float lo, float hi) { bf2_t v = { (__bf16)lo, (__bf16)hi }; return __builtin_bit_cast(unsigned, v); }
DI float bflo(unsigned w) { return __uint_as_float(w << 16); }
DI float bfhi(unsigned w) { return __uint_as_float(w & 0xffff0000u); }
DI float bf1(bf16_t h) { return __uint_as_float(((unsigned)h) << 16); }
DI float wave_sum(float v) {
#pragma unroll
    for (int o = 1; o < 64; o <<= 1) v += __shfl_xor(v, o);
    return v;
}
DI f32x4 mfma16(bf16x8 a, bf16x8 b, f32x4 c) { return __builtin_amdgcn_mfma_f32_16x16x32_bf16(a, b, c, 0, 0, 0); }
DI bf16x8 ldfrag(const LAS bf16_t* base, int ld, int r0, int k0, int lane) { return *(const LAS bf16x8*)(base + (r0 + (lane & 15)) * ld + k0 + (lane >> 4) * 8); }

DI int otid() { int t = threadIdx.x; asm volatile("" : "+v"(t)); return t; }
DI u32x4 ld16_coh(const void* p) { const unsigned long long a = __hip_atomic_load((const unsigned long long*)p, __ATOMIC_RELAXED, __HIP_MEMORY_SCOPE_AGENT), b = __hip_atomic_load((const unsigned long long*)p + 1, __ATOMIC_RELAXED, __HIP_MEMORY_SCOPE_AGENT);
    u32x4 r; r.x = (unsigned)a; r.y = (unsigned)(a >> 32); r.z = (unsigned)b; r.w = (unsigned)(b >> 32); return r; }
struct KArgs { const float* in[23]; float* out; unsigned char* ws; int run, pad1; };

enum { ACT_ID = 0, ACT_SILU = 1, ACT_LOG2F = 2, ACT_SCALE8 = 3, ACT_SIGM = 4, ACT_GELU = 5 };
struct Epi1 {
    static constexpr bool PERM = true, AFTER_DRAIN = false, HAS_MID = false;
    bf16_t* P; bf16_t* BR; float* MLG; const float* bias; const float* lb;
    DI void operator()(const f32x4 (&acc)[2][2][4][2], const pg8::Unit& u, int wr, int wc, int fr, int fq) const {
        const int pn = u.pn, row0 = u.pm * 256 + wr * 64 + fr;
        if (pn == 20) {
            if (wc == 0 && fq < 2) {
                const f32x4 b0 = *(const f32x4*)(bias + 5120 + 8 * fq), b1 = *(const f32x4*)(bias + 5120 + 8 * fq + 4);
#pragma unroll
                for (int ai = 0; ai < 2; ++ai)
#pragma unroll
                    for (int m = 0; m < 4; ++m) { float* dst = MLG + (size_t)(row0 + ai * 128 + m * 16) * 16 + 8 * fq;
                        *(f32x4*)dst = acc[ai][0][m][0] + b0; *(f32x4*)(dst + 4) = acc[ai][0][m][1] + b1; }
            }
            return;
        }
        int act, ldc, colt; bf16_t* base;
        if (pn < 14) { base = P; ldc = NP; colt = pn * 256; act = pn < 2 ? ACT_SILU : (pn < 4 ? ACT_ID : (pn < 8 ? ACT_LOG2F : (pn == 8 ? ACT_SCALE8 : ACT_ID))); }
        else { const int n = (pn - 14) >> 1; base = BR; ldc = 1536; colt = (pn - 14) * 256; act = n == 0 ? ACT_SILU : (n == 1 ? ACT_SIGM : ACT_GELU); }
        const int cin = wc * 32 + 8 * fq, bcol0 = pn * 256 + cin;
        bf16_t* tbase = base + (size_t)row0 * ldc + colt + cin;
        switch (act) {
            case ACT_SILU:   tile<ACT_SILU>(acc, tbase, ldc, bcol0); break;
            case ACT_LOG2F:  tile<ACT_LOG2F>(acc, tbase, ldc, bcol0); break;
            case ACT_SCALE8: tile<ACT_SCALE8>(acc, tbase, ldc, bcol0); break;
            case ACT_SIGM:   tile<ACT_SIGM>(acc, tbase, ldc, bcol0); break;
            case ACT_GELU:   tile<ACT_GELU>(acc, tbase, ldc, bcol0); break;
            default:         tile<ACT_ID>(acc, tbase, ldc, bcol0); break;
        }
    }
    template <int ACT> DI void tile(const f32x4 (&acc)[2][2][4][2], bf16_t* tbase, int ldc, int bcol0) const {
        f32x4 bv[2][2], lbv[2][2];
#pragma unroll
        for (int bj = 0; bj < 2; ++bj)
#pragma unroll
            for (int n = 0; n < 2; ++n) { bv[bj][n] = *(const f32x4*)(bias + bcol0 + bj * 128 + 4 * n);
                lbv[bj][n] = (ACT == ACT_LOG2F) ? *(const f32x4*)(lb + (bcol0 - 1024) + bj * 128 + 4 * n) : (f32x4){0.f, 0.f, 0.f, 0.f}; }
#pragma unroll
        for (int ai = 0; ai < 2; ++ai)
#pragma unroll
            for (int m = 0; m < 4; ++m) { bf16_t* rowp = tbase + (size_t)(ai * 128 + m * 16) * ldc;
#pragma unroll
                for (int bj = 0; bj < 2; ++bj) { f32x4 v[2];
#pragma unroll
                    for (int n = 0; n < 2; ++n) { v[n] = acc[ai][bj][m][n] + bv[bj][n];
#pragma unroll
                        for (int j = 0; j < 4; ++j) { float x = v[n][j];
                            if (ACT == ACT_SILU) x = silu_(x);
                            else if (ACT == ACT_LOG2F) { const float l = lbv[bj][n][j]; x = lg2(l + (1.f - l) * sigm(x)); }
                            else if (ACT == ACT_SCALE8) x *= 0.125f;
                            else if (ACT == ACT_SIGM) x = sigm(x);
                            else if (ACT == ACT_GELU) x = gelu_t(x);
                            v[n][j] = x; } }
                    u32x4 w; w.x = pk2(v[0][0], v[0][1]); w.y = pk2(v[0][2], v[0][3]); w.z = pk2(v[1][0], v[1][1]); w.w = pk2(v[1][2], v[1][3]);
                    *(u32x4*)(rowp + bj * 128) = w; } }
    }
};
struct Epi2 {
    static constexpr bool PERM = true, AFTER_DRAIN = false, HAS_MID = false;
    bf16_t* G; const float* bias;
    DI void operator()(const f32x4 (&acc)[2][2][4][2], const pg8::Unit& u, int wr, int wc, int fr, int fq) const {
        const int row0 = u.pm * 256 + wr * 64 + fr, col0 = u.pn * 256 + wc * 32 + 8 * fq;
        f32x4 bv[2][2];
#pragma unroll
        for (int bj = 0; bj < 2; ++bj)
#pragma unroll
            for (int n = 0; n < 2; ++n) bv[bj][n] = *(const f32x4*)(bias + col0 + bj * 128 + 4 * n);
#pragma unroll
        for (int ai = 0; ai < 2; ++ai)
#pragma unroll
            for (int m = 0; m < 4; ++m) { bf16_t* rowp = G + (size_t)(row0 + ai * 128 + m * 16) * NG + col0;
#pragma unroll
                for (int bj = 0; bj < 2; ++bj) { f32x4 v0 = acc[ai][bj][m][0] + bv[bj][0], v1 = acc[ai][bj][m][1] + bv[bj][1];
#pragma unroll
                    for (int j = 0; j < 4; ++j) { v0[j] = sigm(v0[j]); v1[j] = sigm(v1[j]); }
                    u32x4 w; w.x = pk2(v0[0], v0[1]); w.y = pk2(v0[2], v0[3]); w.z = pk2(v1[0], v1[1]); w.w = pk2(v1[2], v1[3]);
                    *(u32x4*)(rowp + bj * 128) = w; } }
    }
};
struct Epi3 {
    static constexpr bool PERM = true, AFTER_DRAIN = false, HAS_MID = true;
    const bf16_t* G; bf16_t* MG;
    DI void mid(f32x4 (&acc)[2][2][4][2], const pg8::Unit& u, int nb, int wr, int wc, int fr, int fq) const {
        int row0 = u.pm * 256 + wr * 64 + fr, col0 = u.pn * 256 + wc * 32 + 8 * fq;
        asm volatile("" : "+v"(row0), "+v"(col0));
#pragma unroll
        for (int ai = 0; ai < 2; ++ai)
#pragma unroll
            for (int mp = 0; mp < 1; ++mp) { u32x4 ga[4][2], gb[4][2];
#pragma unroll
                for (int mm = 0; mm < 4; ++mm) { const size_t r = (size_t)(row0 + ai * 128 + (4 * mp + mm) * 16);
#pragma unroll
                    for (int bj = 0; bj < 2; ++bj) { ga[mm][bj] = *(const u32x4*)(G + r * NG + (nb - 1) * 1024 + col0 + bj * 128); gb[mm][bj] = *(const u32x4*)(G + r * NG + nb * 1024 + col0 + bj * 128); } }
#pragma unroll
                for (int mm = 0; mm < 4; ++mm) { const int m = 4 * mp + mm;
#pragma unroll
                    for (int bj = 0; bj < 2; ++bj) { const u32x4 a = ga[mm][bj], bq = gb[mm][bj];
                        f32x4 a0 = acc[ai][bj][m][0], a1 = acc[ai][bj][m][1];
                        a0[0] *= bflo(a.x) * rcpf_(bflo(bq.x)); a0[1] *= bfhi(a.x) * rcpf_(bfhi(bq.x)); a0[2] *= bflo(a.y) * rcpf_(bflo(bq.y)); a0[3] *= bfhi(a.y) * rcpf_(bfhi(bq.y));
                        a1[0] *= bflo(a.z) * rcpf_(bflo(bq.z)); a1[1] *= bfhi(a.z) * rcpf_(bfhi(bq.z)); a1[2] *= bflo(a.w) * rcpf_(bflo(bq.w)); a1[3] *= bfhi(a.w) * rcpf_(bfhi(bq.w));
                        acc[ai][bj][m][0] = a0; acc[ai][bj][m][1] = a1; } }
                asm volatile("" ::: "memory"); }
    }
    DI void operator()(const f32x4 (&acc)[2][2][4][2], const pg8::Unit& u, int wr, int wc, int fr, int fq) const {
        const int row0 = u.pm * 256 + wr * 64 + fr, col0 = u.pn * 256 + wc * 32 + 8 * fq;
#pragma unroll
        for (int ai = 0; ai < 2; ++ai) { u32x4 gws[4][2];
#pragma unroll
            for (int m = 0; m < 4; ++m)
#pragma unroll
                for (int bj = 0; bj < 2; ++bj) gws[m][bj] = *(const u32x4*)(G + (size_t)(row0 + ai * 128 + m * 16) * NG + 2 * 1024 + col0 + bj * 128);
#pragma unroll
            for (int m = 0; m < 4; ++m) { const size_t r = (size_t)(row0 + ai * 128 + m * 16);
#pragma unroll
                for (int bj = 0; bj < 2; ++bj) { const u32x4 gw = gws[m][bj];
                    const f32x4 a0 = acc[ai][bj][m][0], a1 = acc[ai][bj][m][1];
                    u32x4 w; w.x = pk2(bflo(gw.x) * a0[0], bfhi(gw.x) * a0[1]); w.y = pk2(bflo(gw.y) * a0[2], bfhi(gw.y) * a0[3]); w.z = pk2(bflo(gw.z) * a1[0], bfhi(gw.z) * a1[1]); w.w = pk2(bflo(gw.w) * a1[2], bfhi(gw.w) * a1[3]);
                    *(u32x4*)(MG + r * 1024 + col0 + bj * 128) = w; } }
            asm volatile("" ::: "memory"); }
    }
};
struct EpiRes {
    static constexpr bool PERM = false, AFTER_DRAIN = false, HAS_MID = false;
    const float* xsrc; float* xdst; const float* csrc; float* cdst; const float* mod; int colmajor; float pscale; int b;
    DI void operator()(const f32x4 (&acc)[2][2][4][2], const pg8::Unit& u, int wr, int wc, int fr, int fq) const {
        const int rowt = u.pm * 256; const bool isx = rowt < 4096; const int bb = isx ? b : 8;
        const float* mrow = mod + bb * 6144; const int col0 = u.pn * 256 + wc * 32 + 4 * fq;
        f32x4 mv[2][2];
#pragma unroll
        for (int bj = 0; bj < 2; ++bj)
#pragma unroll
            for (int n = 0; n < 2; ++n) mv[bj][n] = *(const f32x4*)(mrow + col0 + bj * 128 + n * 16) * pscale;
#pragma unroll
        for (int ai = 0; ai < 2; ++ai)
#pragma unroll
            for (int mp = 0; mp < 1; ++mp) { const float* src[4]; float* dst[4]; f32x4 xin[4][2][2];
#pragma unroll
                for (int mm = 0; mm < 4; ++mm) { const int m = 4 * mp + mm; const int r = rowt + ai * 128 + wr * 64 + m * 16 + fr;
                    if (isx) { const int p = r; const int t = colmajor ? (((p & 63) << 6) | (p >> 6)) : p; const size_t off = ((size_t)(b * 4096 + t)) * 1024 + col0; src[mm] = xsrc + off; dst[mm] = xdst + off; }
                    else { const size_t off = (size_t)(b * 256 + (r - 4096)) * 1024 + col0; src[mm] = csrc + off; dst[mm] = cdst + off; }
#pragma unroll
                    for (int bj = 0; bj < 2; ++bj)
#pragma unroll
                        for (int n = 0; n < 2; ++n) xin[mm][bj][n] = *(const f32x4*)(src[mm] + bj * 128 + n * 16); }
#pragma unroll
                for (int mm = 0; mm < 4; ++mm) { const int m = 4 * mp + mm;
#pragma unroll
                    for (int bj = 0; bj < 2; ++bj)
#pragma unroll
                        for (int n = 0; n < 2; ++n) *(f32x4*)(dst[mm] + bj * 128 + n * 16) = xin[mm][bj][n] + mv[bj][n] * acc[ai][bj][m][n]; }
                asm volatile("" ::: "memory"); }
    }
};
struct Epi5 {
    static constexpr bool PERM = true, AFTER_DRAIN = false, HAS_MID = false;
    bf16_t* H;
    DI void operator()(const f32x4 (&acc)[2][2][4][2], const pg8::Unit& u, int wr, int wc, int fr, int fq) const {
        const int row0 = u.pm * 256 + wr * 64 + fr, col0 = u.pn * 128 + wc * 32 + 8 * fq;
#pragma unroll
        for (int ai = 0; ai < 2; ++ai)
#pragma unroll
            for (int m = 0; m < 4; ++m) { bf16_t* rowp = H + (size_t)(row0 + ai * 128 + m * 16) * FF + col0;
                f32x4 v0, v1;
#pragma unroll
                for (int j = 0; j < 4; ++j) { v0[j] = silu_(acc[ai][0][m][0][j]) * acc[ai][1][m][0][j]; v1[j] = silu_(acc[ai][0][m][1][j]) * acc[ai][1][m][1][j]; }
                u32x4 w; w.x = pk2(v0[0], v0[1]); w.y = pk2(v0[2], v0[3]); w.z = pk2(v1[0], v1[1]); w.w = pk2(v1[2], v1[3]);
                *(u32x4*)rowp = w; }
    }
};
template <class Epi> DI void run_gemm(LAS unsigned char* lds, const bf16_t* A, const bf16_t* Bt, int M, int N, int K, const Epi& E, int gr, int gs) {
    pg8::Gemm g{A, Bt, M, N, K}; pg8::StaticOrder S; S.init(M, N, gs, gr);
    pg8::gemm_phase<Epi, pg8::StaticOrder, PG8_ALIGN_V, PG8_SP2_V>(lds, g, S, E);
}

DI void phase_mod(const KArgs& a, LAS unsigned char* lds, float* MOD, float* LB) {
    LAS float* SC = (LAS float*)lds; LAS float* RED = SC + 9 * 1024;
    const int tid = otid(), lane = tid & 63, w = tid >> 6;
    for (int i = tid; i < 9 * 1024; i += 512) { const int r = i >> 10, k = i & 1023; const float v = r < 8 ? a.in[1][r * 1024 + k] : a.in[3][k]; SC[i] = v / (1.f + __expf(-v)); }
    __syncthreads();
    for (int u = blockIdx.x; u < 4 * 96; u += gridDim.x) {
        const int l = u / 96, n0 = (u % 96) * 64;
        const float* W = a.in[4] + (size_t)l * 1024 * 6144 + n0 + lane;
        float acc[9];
#pragma unroll
        for (int r = 0; r < 9; ++r) acc[r] = 0.f;
#pragma unroll 16
        for (int k = w * 128; k < w * 128 + 128; ++k) { const float wv = __builtin_nontemporal_load(&W[(size_t)k * 6144]);
#pragma unroll
            for (int r = 0; r < 9; ++r) acc[r] += SC[r * 1024 + k] * wv; }
#pragma unroll
        for (int r = 0; r < 9; ++r) RED[(w * 9 + r) * 64 + lane] = acc[r];
        __syncthreads();
        for (int i = tid; i < 9 * 64; i += 512) { const int r = i >> 6, c = i & 63; float s = 0.f;
#pragma unroll
            for (int ww = 0; ww < 8; ++ww) s += RED[(ww * 9 + r) * 64 + c];
            MOD[((size_t)l * 9 + r) * 6144 + n0 + c] = s + a.in[5][l * 6144 + n0 + c]; }
        __syncthreads();
    }
    for (int i = blockIdx.x * 512 + tid; i < 1024; i += gridDim.x * 512) {
        const float r0 = a.in[9][i], r1 = a.in[9][1024 + i], r2 = a.in[9][2048 + i], r3 = a.in[9][3072 + i];
        const float mx = fmaxf(fmaxf(r0, r1), fmaxf(r2, r3));
        const float e0 = __expf(r0 - mx), e1 = __expf(r1 - mx), e2 = __expf(r2 - mx), e3 = __expf(r3 - mx), inv = 1.f / (e0 + e1 + e2 + e3);
        LB[i] = 0.f; LB[1024 + i] = e1 * inv; LB[2048 + i] = (e1 + e2) * inv; LB[3072 + i] = (e1 + e2 + e3) * inv;
    }
}
DI int map_in(int n) {
    if (n < 1024) return n;
    if (n < 1536) return 3584 + (n - 1024);
    if (n < 2560) return 1024 + (n - 1536);
    if (n < 2816) return 2048 + (n - 2560);
    if (n < 3072) return 2304 + (n - 2816);
    if (n < 3584) return 2560 + (n - 3072);
    if (n < 4096) return 4096 + (n - 3584);
    if (n < 4112) return 5120 + (n - 4096);
    if (n < 4624) return 3072 + (n - 4112);
    if (n < 5136) return 4608 + (n - 4624);
    return 5376 + (n - 5136);
}
DI int map_ffn(int n) { return n < FF ? ((n >> 7) * 256 + (n & 127)) : (((n - FF) >> 7) * 256 + 128 + ((n - FF) & 127)); }
template <int MAP> DI void conv_item(const float* W, int K, int N, bf16_t* WT, LAS float* scr, int item, int lane, int ldk = 0) {
    if (ldk == 0) ldk = K;
    const int nblk = (N + 31) / 32, kb = item / nblk, nb = item % nblk, k0 = 64 * kb, n0 = 32 * nb;
    const int nn = n0 + (lane & 31); const bool ok = nn < N;
#pragma unroll 8
    for (int i = 0; i < 32; ++i) { const int kk = 2 * i + (lane >> 5); scr[kk * 33 + (lane & 31)] = ok ? __builtin_nontemporal_load(&W[(size_t)(k0 + kk) * N + nn]) : 0.f; }
    asm volatile("s_waitcnt lgkmcnt(0)" ::: "memory");
    const int c = lane & 7;
#pragma unroll
    for (int j = 0; j < 4; ++j) { const int nl = (lane >> 3) + 8 * j, n = n0 + nl;
        if (n < N) { const LAS float* s = scr + (8 * c) * 33 + nl;
            u32x4 o; o.x = pk2(s[0 * 33], s[1 * 33]); o.y = pk2(s[2 * 33], s[3 * 33]); o.z = pk2(s[4 * 33], s[5 * 33]); o.w = pk2(s[6 * 33], s[7 * 33]);
            const int dr = MAP == 1 ? map_in(n) : (MAP == 2 ? map_ffn(n) : n);
            *(u32x4*)(WT + (size_t)dr * ldk + k0 + 8 * c) = o; } }
    asm volatile("s_waitcnt lgkmcnt(0)" ::: "memory");
}
DI void phase_conv(const KArgs& a, LAS unsigned char* lds, int l, unsigned char* wsw, float* BIAS) {
    const int tid = otid(), lane = tid & 63, w = tid >> 6;
    LAS float* scr = (LAS float*)(lds + w * 16384);
    const int gw = blockIdx.x * 8 + w, NGW = gridDim.x * 8;
    constexpr int I_IN = 16 * 257, I_BR = 8 * 32, I_O = 16 * 32, I_FI = 16 * 176, I_FO = 44 * 32;
    constexpr int NIT = I_IN + 3 * I_BR + I_O + I_FI + I_FO;
    for (int it = gw; it < NIT; it += NGW) {
        int r = it;
        if (r < I_IN) { conv_item<1>(a.in[7] + (size_t)l * 1024 * NIN, 1024, NIN, (bf16_t*)(wsw + W_W1), scr, r, lane); continue; } r -= I_IN;
        if (r < 3 * I_BR) { const int n = r / I_BR; conv_item<0>(a.in[17] + ((size_t)l * 3 + n) * 512 * 1024, 512, 1024, (bf16_t*)(wsw + W_BR) + (size_t)n * 512, scr, r % I_BR, lane, 1536); continue; } r -= 3 * I_BR;
        if (r < I_O) { conv_item<0>(a.in[18] + (size_t)l * 1024 * 1024, 1024, 1024, (bf16_t*)(wsw + W_O), scr, r, lane); continue; } r -= I_O;
        if (r < I_FI) { conv_item<2>(a.in[20] + (size_t)l * 1024 * 2 * FF, 1024, 2 * FF, (bf16_t*)(wsw + W_FI), scr, r, lane); continue; } r -= I_FI;
        conv_item<0>(a.in[21] + (size_t)l * FF * 1024, FF, 1024, (bf16_t*)(wsw + W_FO), scr, r, lane);
    }
    for (int i = blockIdx.x * 512 + tid; i < NIN; i += gridDim.x * 512) BIAS[(size_t)l * NW1 + map_in(i)] = a.in[8][(size_t)l * NIN + i];
    for (int i = blockIdx.x * 512 + tid; i < 240; i += gridDim.x * 512) BIAS[(size_t)l * NW1 + 5136 + i] = 0.f;
}
DI void phase_conv_q(const KArgs& a, LAS unsigned char* lds, int l, unsigned char* wsw, float* BIAS, unsigned* q) {
    const int tid = otid(), lane = tid & 63, w = tid >> 6;
    LAS float* scr = (LAS float*)(lds + w * 16384);
    constexpr int I_IN = 16 * 257, I_BR = 8 * 32, I_O = 16 * 32, I_FI = 16 * 176, I_FO = 44 * 32;
    constexpr int NIT = I_IN + 3 * I_BR + I_O + I_FI + I_FO;
    for (;;) {
        unsigned itv = 0u; if (lane == 0) itv = __hip_atomic_fetch_add(q, 1u, __ATOMIC_RELAXED, __HIP_MEMORY_SCOPE_AGENT);
        const int it = __builtin_amdgcn_readfirstlane((int)itv);
        if (it >= NIT + 18) break;
        int r = it;
        if (r >= NIT) { r -= NIT;
            if (r < 17) {
#pragma unroll
                for (int k = 0; k < 8; ++k) { const int i = r * 512 + k * 64 + lane; if (i < NIN) BIAS[(size_t)l * NW1 + map_in(i)] = a.in[8][(size_t)l * NIN + i]; } }
            else {
#pragma unroll
                for (int k = 0; k < 4; ++k) { const int i = k * 64 + lane; if (i < 240) BIAS[(size_t)l * NW1 + 5136 + i] = 0.f; } }
            continue; }
        if (r < I_IN) { conv_item<1>(a.in[7] + (size_t)l * 1024 * NIN, 1024, NIN, (bf16_t*)(wsw + W_W1), scr, r, lane); continue; } r -= I_IN;
        if (r < 3 * I_BR) { const int n = r / I_BR; conv_item<0>(a.in[17] + ((size_t)l * 3 + n) * 512 * 1024, 512, 1024, (bf16_t*)(wsw + W_BR) + (size_t)n * 512, scr, r % I_BR, lane, 1536); continue; } r -= 3 * I_BR;
        if (r < I_O) { conv_item<0>(a.in[18] + (size_t)l * 1024 * 1024, 1024, 1024, (bf16_t*)(wsw + W_O), scr, r, lane); continue; } r -= I_O;
        if (r < I_FI) { conv_item<2>(a.in[20] + (size_t)l * 1024 * 2 * FF, 1024, 2 * FF, (bf16_t*)(wsw + W_FI), scr, r, lane); continue; } r -= I_FI;
        conv_item<0>(a.in[21] + (size_t)l * FF * 1024, FF, 1024, (bf16_t*)(wsw + W_FO), scr, r, lane);
    }
}
DI void norm_row(const float* src, const float* lnw, const float* shift, const float* scale, bf16_t* dst, int lane) {
    const f32x4* xr = (const f32x4*)src + lane; f32x4 v[4]; float s = 0.f;
#pragma unroll
    for (int j = 0; j < 4; ++j) { v[j] = xr[64 * j]; s += (v[j].x * v[j].x + v[j].y * v[j].y) + (v[j].z * v[j].z + v[j].w * v[j].w); }
    const float rstd = rsqrtf(wave_sum(s) * (1.f / D) + EPS);
#pragma unroll
    for (int j = 0; j < 4; ++j) { const int c = 4 * lane + 256 * j; const f32x4 w = *(const f32x4*)(lnw + c), sh = *(const f32x4*)(shift + c), sc = *(const f32x4*)(scale + c);
        const f32x4 y = v[j] * rstd * w * (sc + 1.f) + sh; u32x2 o; o.x = pk2(y.x, y.y); o.y = pk2(y.z, y.w); *(u32x2*)(dst + c) = o; }
}
DI const float* src_row(int m, int b, const float* xs, const float* cs, int colmajor, int& modrow) {
    if (m < 4096) { const int p = m, t = colmajor ? (((p & 63) << 6) | (p >> 6)) : p; modrow = b; return xs + ((size_t)(b * 4096 + t)) * 1024; }
    modrow = 8; return cs + (size_t)(b * 256 + (m - 4096)) * 1024;
}
DI void phase_norm(const float* xs, const float* cs, const float* lnw, const float* modl, int ksh, int ksc, int colmajor, bf16_t* AS, int Mrows, int b, int gr, int gs) {
    const int tid = otid(); const int lane = tid & 63, gw = gr * 8 + (tid >> 6), NGW = gs * 8;
    f32x4 wf[4], sf[4], nv[4]; int curmr = -1; int m = gw;
    if (m < Mrows) { int mr; const f32x4* xr = (const f32x4*)src_row(m, b, xs, cs, colmajor, mr) + lane;
#pragma unroll
        for (int j = 0; j < 4; ++j) nv[j] = __builtin_nontemporal_load(&xr[64 * j]); }
    while (m < Mrows) {
        f32x4 v[4];
#pragma unroll
        for (int j = 0; j < 4; ++j) v[j] = nv[j];
        const int mr = (m < 4096) ? b : 8, mn = m + NGW;
        if (mn < Mrows) { int mr2; const f32x4* xr = (const f32x4*)src_row(mn, b, xs, cs, colmajor, mr2) + lane;
#pragma unroll
            for (int j = 0; j < 4; ++j) nv[j] = __builtin_nontemporal_load(&xr[64 * j]); }
        if (mr != curmr) { curmr = mr;
#pragma unroll
            for (int j = 0; j < 4; ++j) { const int c = 4 * lane + 256 * j; wf[j] = *(const f32x4*)(lnw + c) * (*(const f32x4*)(modl + mr * 6144 + ksc * 1024 + c) + 1.f); sf[j] = *(const f32x4*)(modl + mr * 6144 + ksh * 1024 + c); } }
        float s = 0.f;
#pragma unroll
        for (int j = 0; j < 4; ++j) s += (v[j].x * v[j].x + v[j].y * v[j].y) + (v[j].z * v[j].z + v[j].w * v[j].w);
        const float rstd = rsqrtf(wave_sum(s) * (1.f / D) + EPS);
        bf16_t* dst = AS + (size_t)m * 1024;
#pragma unroll
        for (int j = 0; j < 4; ++j) { const f32x4 y = v[j] * rstd * wf[j] + sf[j]; u32x2 o; o.x = pk2(y.x, y.y); o.y = pk2(y.z, y.w); *(u32x2*)(dst + 4 * lane + 256 * j) = o; }
        m = mn;
    }
}
DI void phase_fin(const float* xs, const float* cs, const float* lnw, const float* modl, int colmajor, bf16_t* AS, bf16_t* SL, bf16_t* BR, const float* hgn, const float* mln, int Mrows, int b, int gr, int gs) {
    const int tid = otid(); const int lane = tid & 63, gw = gr * 8 + (tid >> 6), NGW = gs * 8;
    const int cb = (16 * lane) & 511; const float* nwp = (lane < 32 ? hgn : mln) + cb;
    f32x4 nw4[4];
#pragma unroll
    for (int j = 0; j < 4; ++j) nw4[j] = *(const f32x4*)(nwp + 4 * j);
    f32x4 wf[4], sf[4]; int curmr = -1; int m = gw;
    u32x4 ns0, ns1, ng0, ng1, nsl, ng2; f32x4 nv[4];
#define FIN_LOAD(mm) do { const bf16_t* ap = AS + (size_t)(mm) * 1024 + 16 * lane; ns0 = *(const u32x4*)ap; ns1 = *(const u32x4*)(ap + 8); const bf16_t* gp_ = BR + (size_t)(mm) * 1536 + 16 * lane; ng0 = *(const u32x4*)gp_; ng1 = *(const u32x4*)(gp_ + 8); \
        nsl = *(const u32x4*)(SL + (size_t)(mm) * 512 + 8 * lane); ng2 = *(const u32x4*)(BR + (size_t)(mm) * 1536 + 1024 + 8 * lane); \
        int mr_; const f32x4* xr = (const f32x4*)src_row((mm), b, xs, cs, colmajor, mr_) + lane; _Pragma("unroll") for (int j = 0; j < 4; ++j) nv[j] = __builtin_nontemporal_load(&xr[64 * j]); } while (0)
    if (m < Mrows) FIN_LOAD(m);
    while (m < Mrows) {
        const u32x4 s0 = ns0, s1 = ns1, g0 = ng0, g1 = ng1, sl = nsl, g2 = ng2; f32x4 v[4];
#pragma unroll
        for (int j = 0; j < 4; ++j) v[j] = nv[j];
        const int mr = (m < 4096) ? b : 8, mn = m + NGW;
        if (mn < Mrows) FIN_LOAD(mn);
        if (mr != curmr) { curmr = mr;
#pragma unroll
            for (int j = 0; j < 4; ++j) { const int c = 4 * lane + 256 * j; wf[j] = *(const f32x4*)(lnw + c) * (*(const f32x4*)(modl + mr * 6144 + 1024 + c) + 1.f); sf[j] = *(const f32x4*)(modl + mr * 6144 + c); } }
        {
            float sv[16] = { bflo(s0.x), bfhi(s0.x), bflo(s0.y), bfhi(s0.y), bflo(s0.z), bfhi(s0.z), bflo(s0.w), bfhi(s0.w), bflo(s1.x), bfhi(s1.x), bflo(s1.y), bfhi(s1.y), bflo(s1.z), bfhi(s1.z), bflo(s1.w), bfhi(s1.w) };
            float ss = 0.f;
#pragma unroll
            for (int j = 0; j < 16; ++j) ss += sv[j] * sv[j];
            ss += __shfl_xor(ss, 1); ss += __shfl_xor(ss, 2); ss += __shfl_xor(ss, 4);
            const float rstd = rsqrtf(ss * (1.f / 128.f) + EPS);
            const float g[16] = { bflo(g0.x), bfhi(g0.x), bflo(g0.y), bfhi(g0.y), bflo(g0.z), bfhi(g0.z), bflo(g0.w), bfhi(g0.w), bflo(g1.x), bfhi(g1.x), bflo(g1.y), bfhi(g1.y), bflo(g1.z), bfhi(g1.z), bflo(g1.w), bfhi(g1.w) };
            float o[16];
#pragma unroll
            for (int j = 0; j < 16; ++j) o[j] = sv[j] * rstd * nw4[j >> 2][j & 3] * g[j];
            u32x4 w0, w1; w0.x = pk2(o[0], o[1]); w0.y = pk2(o[2], o[3]); w0.z = pk2(o[4], o[5]); w0.w = pk2(o[6], o[7]); w1.x = pk2(o[8], o[9]); w1.y = pk2(o[10], o[11]); w1.z = pk2(o[12], o[13]); w1.w = pk2(o[14], o[15]);
            bf16_t* gp = BR + (size_t)m * 1536 + 16 * lane; ((u32x4*)gp)[0] = w0; ((u32x4*)gp)[1] = w1;
        }
        {
            u32x4 w; w.x = pk2(bflo(sl.x) * bflo(g2.x), bfhi(sl.x) * bfhi(g2.x)); w.y = pk2(bflo(sl.y) * bflo(g2.y), bfhi(sl.y) * bfhi(g2.y)); w.z = pk2(bflo(sl.z) * bflo(g2.z), bfhi(sl.z) * bfhi(g2.z)); w.w = pk2(bflo(sl.w) * bflo(g2.w), bfhi(sl.w) * bfhi(g2.w));
            *(u32x4*)(BR + (size_t)m * 1536 + 1024 + 8 * lane) = w;
        }
        {
            float s = 0.f;
#pragma unroll
            for (int j = 0; j < 4; ++j) s += (v[j].x * v[j].x + v[j].y * v[j].y) + (v[j].z * v[j].z + v[j].w * v[j].w);
            const float rstd = rsqrtf(wave_sum(s) * (1.f / D) + EPS);
            bf16_t* dst = AS + (size_t)m * 1024;
#pragma unroll
            for (int j = 0; j < 4; ++j) { const f32x4 y = v[j] * rstd * wf[j] + sf[j]; u32x2 o2; o2.x = pk2(y.x, y.y); o2.y = pk2(y.z, y.w); *(u32x2*)(dst + 4 * lane + 256 * j) = o2; }
        }
        m = mn;
    }
#undef FIN_LOAD
}
DI void phase_final(float* out, const float* fw, int gr, int gs) {
    const int tid = otid(); const int lane = tid & 63, gw = gr * 8 + (tid >> 6), NGW = gs * 8;
    f32x4 wv[4], nv[4];
#pragma unroll
    for (int j = 0; j < 4; ++j) wv[j] = *(const f32x4*)(fw + 4 * lane + 256 * j);
    int m = gw;
    if (m < 4096) { const f32x4* xr = (const f32x4*)(out + (size_t)m * 1024) + lane;
#pragma unroll
        for (int j = 0; j < 4; ++j) nv[j] = __builtin_nontemporal_load(&xr[64 * j]); }
    while (m < 4096) { f32x4 v[4]; float s = 0.f;
#pragma unroll
        for (int j = 0; j < 4; ++j) { v[j] = nv[j]; s += (v[j].x * v[j].x + v[j].y * v[j].y) + (v[j].z * v[j].z + v[j].w * v[j].w); }
        const int mn = m + NGW;
        if (mn < 4096) { const f32x4* xr = (const f32x4*)(out + (size_t)mn * 1024) + lane;
#pragma unroll
            for (int j = 0; j < 4; ++j) nv[j] = __builtin_nontemporal_load(&xr[64 * j]); }
        const float rstd = rsqrtf(wave_sum(s) * (1.f / D) + EPS);
        f32x4* xo = (f32x4*)(out + (size_t)m * 1024) + lane;
#pragma unroll
        for (int j = 0; j < 4; ++j) xo[64 * j] = v[j] * rstd * wv[j];
        m = mn; }
}

struct ScanArgs { const bf16_t* P; const float* MLG; bf16_t* AS; bf16_t* SL; const float* convw; const float* convb; const float* gw; const float* gb; const float* lam; int last; };
DI void chunk_geom(int j, int b, int dir, int& rowbase, int& pos0, int& slen, bool& first, bool& isx) {
    isx = j >= 4; const int cj = isx ? j - 4 : j, nch = isx ? 64 : 4, pc = dir ? nch - 1 - cj : cj;
    pos0 = pc * 64; slen = nch * 64; rowbase = (isx ? 0 : 4096) + pc * 64; first = cj < nch / 2; (void)b;
}
DI void out_rmw4(bf16_t* p, f32x4 v, bool first) {
    if (!first) { const unsigned long long w = __hip_atomic_load((unsigned long long*)p, __ATOMIC_RELAXED, __HIP_MEMORY_SCOPE_AGENT); const unsigned lo = (unsigned)w, hi = (unsigned)(w >> 32);
        v[0] += bflo(lo); v[1] += bfhi(lo); v[2] += bflo(hi); v[3] += bfhi(hi); }
    u32x2 o; o.x = pk2(v[0], v[1]); o.y = pk2(v[2], v[3]); *(u32x2*)p = o;
}
DI unsigned long long ld8_coh(const bf16_t* p) { return __hip_atomic_load((const unsigned long long*)p, __ATOMIC_RELAXED, __HIP_MEMORY_SCOPE_AGENT); }
DI void out_put4(bf16_t* p, f32x4 v, int mode, unsigned long long pre) {
    if (mode != 0) { const unsigned long long w = pre; const unsigned lo = (unsigned)w, hi = (unsigned)(w >> 32);
        v[0] += bflo(lo); v[1] += bfhi(lo); v[2] += bflo(hi); v[3] += bfhi(hi); }
    u32x2 o; o.x = pk2(v[0], v[1]); o.y = pk2(v[2], v[3]); *(u32x2*)p = o;
}
DI int pre_mode(bool first, int jn) { (void)jn; return first ? 0 : 1; }
DI bool late_pre(int jn) { return jn == 2 || jn == 36; }
constexpr int NSTEP = 68;
constexpr float ECLAMP = 120.f;

#define LBAR() do { asm volatile("s_waitcnt lgkmcnt(0)" ::: "memory"); __builtin_amdgcn_s_barrier(); asm volatile("" ::: "memory"); } while (0)
DI void scan_hgrn2(const ScanArgs& A, LAS unsigned char* lds, int unit) {
    const int tid = otid(), dir = tid >> 8, ht = tid & 255, hw = ht >> 6, lane = tid & 63, fr = lane & 15, fq = lane >> 4;
    const int b = 0, h = (unit >> 2) & 3, vs = unit & 3;
    LAS unsigned char* L = lds + dir * 76800;
    LAS bf16_t* Qt = (LAS bf16_t*)L;
    LAS bf16_t* Kt = Qt + 64 * 136;
    LAS bf16_t* KtT = Kt + 64 * 136;
    LAS bf16_t* Vt = KtT + 128 * 72;
    LAS bf16_t* Sc = Vt + 32 * 72;
    LAS bf16_t* Sb = Sc + 64 * 72;
    LAS float* GT = (LAS float*)Sc;
    LAS float* E2 = (LAS float*)(Sb + 32 * 136);
    LAS float* DEC = E2 + 128;
    const bf16_t* Pq = A.P + h * 128 + 2 * lane;
    const bf16_t* Pf = A.P + 1024 + dir * 512 + h * 128 + 2 * lane;
    const bf16_t* Pv = A.P + 512 + h * 128 + vs * 32 + (ht & 3) * 8;
    unsigned qw[16], fw[16]; u32x4 vv; unsigned long long pr[2] = {0ull, 0ull}; int pmode = 0;
    bf16_t* const opb = A.AS + h * 128 + vs * 32 + 4 * fq;
    f32x4 S[2][2];
#pragma unroll
    for (int a = 0; a < 2; ++a)
#pragma unroll
        for (int c = 0; c < 2; ++c) S[a][c] = (f32x4){0.f, 0.f, 0.f, 0.f};
    int rowbase, pos0, slen; bool first, isx;
    chunk_geom(0, b, dir, rowbase, pos0, slen, first, isx);
#define HG_LOAD() do { \
        _Pragma("unroll") for (int i = 0; i < 16; ++i) { const int t = 16 * hw + i; const size_t r = (size_t)(rowbase + (dir ? 63 - t : t)) * NP; qw[i] = *(const unsigned*)(Pq + r); fw[i] = *(const unsigned*)(Pf + r); } \
        { const int t = ht >> 2; vv = __builtin_nontemporal_load((const u32x4*)(Pv + (size_t)(rowbase + (dir ? 63 - t : t)) * NP)); } \
        if (pmode == 1 && !late_pre(jnx)) { const int t = 16 * hw + fr; const bf16_t* op = opb + (size_t)(rowbase + (dir ? 63 - t : t)) * 1024; pr[0] = ld8_coh(op); pr[1] = ld8_coh(op + 16); } } while (0)
    int jnx = 0;
    pmode = (A.last && !isx) ? 0 : pre_mode(first, 0);
    HG_LOAD();
    for (int j = 0; j < NSTEP; ++j) {
        const int orow = rowbase; const bool owrite = !(A.last && !isx); const int omode = pmode;
        if (late_pre(j) && pmode == 1) { const int t = 16 * hw + fr; const bf16_t* op = opb + (size_t)(rowbase + (dir ? 63 - t : t)) * 1024; pr[0] = ld8_coh(op); pr[1] = ld8_coh(op + 16); }
        unsigned long long opr0 = pr[0], opr1 = pr[1];
        asm volatile("" : "+v"(opr0), "+v"(opr1));
        float c0[16], c1[16]; float r0 = 0.f, r1 = 0.f;
#pragma unroll
        for (int i = 0; i < 16; ++i) { r0 += bflo(fw[i]); r1 += bfhi(fw[i]); c0[i] = r0; c1[i] = r1; }
        GT[hw * 128 + 2 * lane] = r0; GT[hw * 128 + 2 * lane + 1] = r1;
        { const int t = ht >> 2, v0 = (ht & 3) * 8; const unsigned vw[4] = {vv.x, vv.y, vv.z, vv.w};
#pragma unroll
            for (int e = 0; e < 4; ++e) { Vt[(v0 + 2 * e) * 72 + t] = (bf16_t)(vw[e] & 0xffffu); Vt[(v0 + 2 * e + 1) * 72 + t] = (bf16_t)(vw[e] >> 16); } }
        LBAR();
        {
            const float g00 = GT[2 * lane], g01 = GT[128 + 2 * lane], g02 = GT[256 + 2 * lane], g03 = GT[384 + 2 * lane];
            const float g10 = GT[2 * lane + 1], g11 = GT[128 + 2 * lane + 1], g12 = GT[256 + 2 * lane + 1], g13 = GT[384 + 2 * lane + 1];
            const float ref0 = g00 + g01, ref1 = g10 + g11, tot0 = ref0 + g02 + g03, tot1 = ref1 + g12 + g13;
            const float pre0 = hw == 0 ? 0.f : (hw == 1 ? g00 : (hw == 2 ? ref0 : ref0 + g02));
            const float pre1 = hw == 0 ? 0.f : (hw == 1 ? g10 : (hw == 2 ? ref1 : ref1 + g12));
            unsigned kp0[8], kp1[8];
            const float bs0 = fminf(fmaxf(pre0 - ref0, -ECLAMP), ECLAMP), bs1 = fminf(fmaxf(pre1 - ref1, -ECLAMP), ECLAMP);
            const float sq0 = ex2(bs0), sk0 = ex2(-bs0), sq1 = ex2(bs1), sk1 = ex2(-bs1);
            float E0 = 1.f, E1 = 1.f;
#pragma unroll
            for (int i = 0; i < 16; ++i) {
                const int t = 16 * hw + i;
                const float f0 = ex2(bflo(fw[i])), f1 = ex2(bfhi(fw[i]));
                E0 *= f0; E1 *= f1;
                const float eq0 = sq0 * E0, eq1 = sq1 * E1;
                const float ek0 = fminf(sk0 * rcpf_(E0), 1.3e36f), ek1 = fminf(sk1 * rcpf_(E1), 1.3e36f);
                const float q0 = bflo(qw[i]) * eq0, q1 = bfhi(qw[i]) * eq1;
                const float k0 = (1.f - f0) * ek0, k1 = (1.f - f1) * ek1;
                *(LAS unsigned*)(Qt + t * 136 + 2 * lane) = pk2(q0, q1);
                const unsigned kk = pk2(k0, k1);
                *(LAS unsigned*)(Kt + t * 136 + 2 * lane) = kk;
                if (i & 1) { kp0[i >> 1] |= (kk << 16); kp1[i >> 1] |= (kk & 0xffff0000u); } else { kp0[i >> 1] = kk & 0xffffu; kp1[i >> 1] = kk >> 16; }
            }
            { u32x4 w; w.x = kp0[0]; w.y = kp0[1]; w.z = kp0[2]; w.w = kp0[3]; *(LAS u32x4*)(KtT + (2 * lane) * 72 + 16 * hw) = w; w.x = kp0[4]; w.y = kp0[5]; w.z = kp0[6]; w.w = kp0[7]; *(LAS u32x4*)(KtT + (2 * lane) * 72 + 16 * hw + 8) = w;
              w.x = kp1[0]; w.y = kp1[1]; w.z = kp1[2]; w.w = kp1[3]; *(LAS u32x4*)(KtT + (2 * lane + 1) * 72 + 16 * hw) = w; w.x = kp1[4]; w.y = kp1[5]; w.z = kp1[6]; w.w = kp1[7]; *(LAS u32x4*)(KtT + (2 * lane + 1) * 72 + 16 * hw + 8) = w; }
            if (hw == 0) { E2[2 * lane] = ex2(tot0 - ref0); E2[2 * lane + 1] = ex2(tot1 - ref1); DEC[2 * lane] = ex2(tot0); DEC[2 * lane + 1] = ex2(tot1); }
#pragma unroll
            for (int a = 0; a < 2; ++a) { const int kb = 16 * (2 * hw + a) + 4 * fq; float sc4[4];
#pragma unroll
                for (int i = 0; i < 4; ++i) sc4[i] = ex2(GT[kb + i] + GT[128 + kb + i]);
#pragma unroll
                for (int c = 0; c < 2; ++c) { u32x2 w; w.x = pk2(S[a][c][0] * sc4[0], S[a][c][1] * sc4[1]); w.y = pk2(S[a][c][2] * sc4[2], S[a][c][3] * sc4[3]); *(LAS u32x2*)(Sb + (16 * c + fr) * 136 + kb) = w; } }
        }
        LBAR();
        if (j + 1 < NSTEP) { chunk_geom(j + 1, b, dir, rowbase, pos0, slen, first, isx); pmode = (A.last && !isx) ? 0 : pre_mode(first, j + 1); jnx = j + 1; HG_LOAD(); }
#pragma unroll
        for (int st = 0; st < 4; ++st) {
            f32x4 acc = (f32x4){0.f, 0.f, 0.f, 0.f};
            if (st <= hw) {
#pragma unroll
                for (int kk = 0; kk < 4; ++kk) acc = mfma16(ldfrag(Kt, 136, 16 * st, 32 * kk, lane), ldfrag(Qt, 136, 16 * hw, 32 * kk, lane), acc);
                if (st == hw) {
#pragma unroll
                    for (int i = 0; i < 4; ++i) acc[i] = (4 * fq + i <= fr) ? acc[i] : 0.f;
                }
            }
            u32x2 w; w.x = pk2(acc[0], acc[1]); w.y = pk2(acc[2], acc[3]);
            *(LAS u32x2*)(Sc + (16 * hw + fr) * 72 + 16 * st + 4 * fq) = w;
        }
        {
            const int t = 16 * hw + fr; bf16_t* op = opb + (size_t)(orow + (dir ? 63 - t : t)) * 1024;
#pragma unroll
            for (int c = 0; c < 2; ++c) { f32x4 acc = (f32x4){0.f, 0.f, 0.f, 0.f};
#pragma unroll
                for (int ks = 0; ks < 2; ++ks) acc = mfma16(ldfrag(Vt, 72, 16 * c, 32 * ks, lane), ldfrag(Sc, 72, 16 * hw, 32 * ks, lane), acc);
#pragma unroll
                for (int kk = 0; kk < 4; ++kk) acc = mfma16(ldfrag(Sb, 136, 16 * c, 32 * kk, lane), ldfrag(Qt, 136, 16 * hw, 32 * kk, lane), acc);
                if (owrite) out_put4(op + 16 * c, acc, omode, c == 0 ? opr0 : opr1); }
        }
#pragma unroll
        for (int a = 0; a < 2; ++a) { const int kb = 16 * (2 * hw + a);
            f32x4 dk, ek;
#pragma unroll
            for (int i = 0; i < 4; ++i) { dk[i] = DEC[kb + 4 * fq + i]; ek[i] = E2[kb + 4 * fq + i]; }
#pragma unroll
            for (int c = 0; c < 2; ++c) { f32x4 d = (f32x4){0.f, 0.f, 0.f, 0.f};
#pragma unroll
                for (int ks = 0; ks < 2; ++ks) d = mfma16(ldfrag(KtT, 72, kb, 32 * ks, lane), ldfrag(Vt, 72, 16 * c, 32 * ks, lane), d);
                S[a][c] = S[a][c] * dk + d * ek; } }
        if (j == 1 || j == 35) asm volatile("s_waitcnt vmcnt(0)" ::: "memory");
        LBAR();
    }
#undef HG_LOAD
}

DI void scan_mlstm(const ScanArgs& A, LAS unsigned char* lds, int unit) {
    const int tid = otid(), dir = tid >> 8, ht = tid & 255, hw = ht >> 6, lane = tid & 63, fr = lane & 15, fq = lane >> 4;
    const int b = 0, h = (unit >> 1) & 3, vs = unit & 1;
    LAS unsigned char* L = lds + dir * 63488;
    LAS bf16_t* Qs = (LAS bf16_t*)L;
    LAS bf16_t* Ks = Qs + 64 * 72;
    LAS bf16_t* KhT = Ks + 64 * 72;
    LAS bf16_t* Vt = KhT + 64 * 72;
    LAS bf16_t* Sc = Vt + 80 * 72;
    LAS bf16_t* Cb = Sc + 64 * 72;
    LAS float* G2 = (LAS float*)(Cb + 80 * 72);
    LAS float* M2 = G2 + 64; LAS float* WI = M2 + 64; LAS float* EM = WI + 64; LAS float* WS = EM + 64; LAS float* MISC = WS + 64;
    for (int i = ht; i < 16 * 72; i += 256) Vt[64 * 72 + i] = (i < 72) ? (bf16_t)0x3F80u : (bf16_t)0u;
    const int t_ld = ht >> 2, cg = ht & 3;
    const bf16_t* Pq = A.P + 2048 + h * 64 + cg * 16;
    const bf16_t* Pk = A.P + 2304 + h * 64 + cg * 16;
    const bf16_t* Pv = A.P + 2560 + h * 128 + vs * 64 + cg * 16;
    u32x4 rq[2], rk[2], rv[2]; float rig = 0.f, rfg = 0.f; unsigned long long pr[4] = {0ull, 0ull, 0ull, 0ull}; int pmode = 0;
    bf16_t* const opb = A.AS + 512 + h * 128 + vs * 64 + 4 * fq;
    f32x4 C[5];
#pragma unroll
    for (int c = 0; c < 5; ++c) C[c] = (f32x4){0.f, 0.f, 0.f, 0.f};
    float m2prev = 0.f;
    int rowbase, pos0, slen; bool first, isx;
    chunk_geom(0, b, dir, rowbase, pos0, slen, first, isx);
#define ML_LOAD() do { const size_t r = (size_t)(rowbase + (dir ? 63 - t_ld : t_ld)) * NP; \
        rq[0] = *(const u32x4*)(Pq + r); rq[1] = *(const u32x4*)(Pq + r + 8); rk[0] = *(const u32x4*)(Pk + r); rk[1] = *(const u32x4*)(Pk + r + 8); rv[0] = __builtin_nontemporal_load((const u32x4*)(Pv + r)); rv[1] = __builtin_nontemporal_load((const u32x4*)(Pv + r + 8)); \
        if (hw == 0) { const float* g = A.MLG + (size_t)(rowbase + (dir ? 63 - lane : lane)) * 16 + dir * 4 + h; rig = g[0]; rfg = g[8]; } \
        if (pmode == 1 && !late_pre(jnx)) { const int t = 16 * hw + fr; const bf16_t* op = opb + (size_t)(rowbase + (dir ? 63 - t : t)) * 1024; _Pragma("unroll") for (int c = 0; c < 4; ++c) pr[c] = ld8_coh(op + 16 * c); } } while (0)
    int jnx = 0;
    pmode = (A.last && !isx) ? 0 : pre_mode(first, 0);
    ML_LOAD();
    for (int j = 0; j < NSTEP; ++j) {
        const int orow = rowbase; const bool owrite = !(A.last && !isx); const int omode = pmode;
        if (late_pre(j) && pmode == 1) { const int t = 16 * hw + fr; const bf16_t* op = opb + (size_t)(rowbase + (dir ? 63 - t : t)) * 1024; _Pragma("unroll") for (int c = 0; c < 4; ++c) pr[c] = ld8_coh(op + 16 * c); }
        unsigned long long opr[4] = {pr[0], pr[1], pr[2], pr[3]};
        asm volatile("" : "+v"(opr[0]), "+v"(opr[1]), "+v"(opr[2]), "+v"(opr[3]));
#pragma unroll
        for (int c = 0; c < 5; ++c) { u32x2 w; w.x = pk2(C[c][0], C[c][1]); w.y = pk2(C[c][2], C[c][3]); *(LAS u32x2*)(Cb + (16 * c + fr) * 72 + 16 * hw + 4 * fq) = w; }
        *(LAS u32x4*)(Qs + t_ld * 72 + cg * 16) = rq[0]; *(LAS u32x4*)(Qs + t_ld * 72 + cg * 16 + 8) = rq[1];
        *(LAS u32x4*)(Ks + t_ld * 72 + cg * 16) = rk[0]; *(LAS u32x4*)(Ks + t_ld * 72 + cg * 16 + 8) = rk[1];
        { const unsigned vw[8] = {rv[0].x, rv[0].y, rv[0].z, rv[0].w, rv[1].x, rv[1].y, rv[1].z, rv[1].w};
#pragma unroll
            for (int e = 0; e < 8; ++e) { Vt[(cg * 16 + 2 * e) * 72 + t_ld] = (bf16_t)(vw[e] & 0xffffu); Vt[(cg * 16 + 2 * e + 1) * 72 + t_ld] = (bf16_t)(vw[e] >> 16); } }
        if (hw == 0) {
            const float i2 = rig * LOG2E, lf2 = -lg2(1.f + ex2(-rfg * LOG2E));
            float b2 = lf2;
#pragma unroll
            for (int o = 1; o < 64; o <<= 1) { const float y = __shfl_up(b2, o); if (lane >= o) b2 += y; }
            const float g2 = i2 - b2; float pm = g2;
#pragma unroll
            for (int o = 1; o < 64; o <<= 1) { const float y = __shfl_up(pm, o); if (lane >= o) pm = fmaxf(pm, y); }
            const float m2 = fmaxf(pm, m2prev);
            const float m63 = __shfl(m2, 63), b63 = __shfl(b2, 63);
            G2[lane] = g2; M2[lane] = m2; WI[lane] = ex2(m2prev - m2); EM[lane] = ex2(fminf(-(b2 + m2), ECLAMP)); WS[lane] = ex2(g2 - m63);
            if (lane == 0) MISC[0] = ex2(m2prev - m63);
            m2prev = b63 + m63;
        }
        LBAR();
        { const float ws = WS[t_ld]; const unsigned kw[8] = {rk[0].x, rk[0].y, rk[0].z, rk[0].w, rk[1].x, rk[1].y, rk[1].z, rk[1].w};
#pragma unroll
            for (int e = 0; e < 8; ++e) { const unsigned p = pk2(bflo(kw[e]) * ws, bfhi(kw[e]) * ws); KhT[(cg * 16 + 2 * e) * 72 + t_ld] = (bf16_t)(p & 0xffffu); KhT[(cg * 16 + 2 * e + 1) * 72 + t_ld] = (bf16_t)(p >> 16); } }
        LBAR();
        if (j + 1 < NSTEP) { chunk_geom(j + 1, b, dir, rowbase, pos0, slen, first, isx); pmode = (A.last && !isx) ? 0 : pre_mode(first, j + 1); jnx = j + 1; ML_LOAD(); }
        const int t = 16 * hw + fr; const float mt = M2[t];
#pragma unroll
        for (int st = 0; st < 4; ++st) {
            f32x4 acc = (f32x4){0.f, 0.f, 0.f, 0.f};
            if (st <= hw) {
#pragma unroll
                for (int kk = 0; kk < 2; ++kk) acc = mfma16(ldfrag(Ks, 72, 16 * st, 32 * kk, lane), ldfrag(Qs, 72, 16 * hw, 32 * kk, lane), acc);
#pragma unroll
                for (int i = 0; i < 4; ++i) { const float wgt = ex2(G2[16 * st + 4 * fq + i] - mt); acc[i] = (st < hw || 4 * fq + i <= fr) ? acc[i] * wgt : 0.f; }
            }
            u32x2 w; w.x = pk2(acc[0], acc[1]); w.y = pk2(acc[2], acc[3]);
            *(LAS u32x2*)(Sc + (16 * hw + fr) * 72 + 16 * st + 4 * fq) = w;
        }
        {
            f32x4 nu[5]; const float wi = WI[t];
#pragma unroll
            for (int c = 0; c < 5; ++c) { f32x4 a1 = (f32x4){0.f, 0.f, 0.f, 0.f}, a2 = (f32x4){0.f, 0.f, 0.f, 0.f};
#pragma unroll
                for (int ks = 0; ks < 2; ++ks) a1 = mfma16(ldfrag(Vt, 72, 16 * c, 32 * ks, lane), ldfrag(Sc, 72, 16 * hw, 32 * ks, lane), a1);
#pragma unroll
                for (int kk = 0; kk < 2; ++kk) a2 = mfma16(ldfrag(Cb, 72, 16 * c, 32 * kk, lane), ldfrag(Qs, 72, 16 * hw, 32 * kk, lane), a2);
                nu[c] = a1 + a2 * wi; }
            const float den = __shfl(nu[4][0], fr);
            const float inv = rcpf_(fmaxf(fabsf(den), EM[t]));
            bf16_t* op = opb + (size_t)(orow + (dir ? 63 - t : t)) * 1024;
            if (owrite) {
#pragma unroll
                for (int c = 0; c < 4; ++c) out_put4(op + 16 * c, nu[c] * inv, omode, opr[c]); }
        }
        { const float carry = MISC[0];
#pragma unroll
            for (int c = 0; c < 5; ++c) { f32x4 d = C[c] * carry;
#pragma unroll
                for (int ks = 0; ks < 2; ++ks) d = mfma16(ldfrag(KhT, 72, 16 * hw, 32 * ks, lane), ldfrag(Vt, 72, 16 * c, 32 * ks, lane), d);
                C[c] = d; } }
        if (j == 1 || j == 35) asm volatile("s_waitcnt vmcnt(0)" ::: "memory");
        LBAR();
    }
#undef ML_LOAD
}

DI void scan_lru(const ScanArgs& A, LAS unsigned char* lds, int unit) {
    const int tid = otid(), dir = tid >> 8, ht = tid & 255, hw = ht >> 6, lane = tid & 63, fr = lane & 15, fq = lane >> 4;
    const int b = 0, nbk = unit & 7;
    LAS unsigned char* L = lds + dir * 76288;
    LAS bf16_t* WG = (LAS bf16_t*)L;
    LAS bf16_t* XC = WG + 2 * 64 * 72;
    LAS bf16_t* XR = XC + 64 * 72;
    LAS float* AA = (LAS float*)(XR + 68 * 64);
    LAS float* UU = AA + 64 * 68;
    LAS float* CW = UU + 64 * 68;
    LAS float* CB = CW + 256; LAS float* BRr = CB + 64; LAS float* BIi = BRr + 64; LAS float* C8 = BIi + 64; LAS float* SEGA = C8 + 64; LAS float* SEGH = SEGA + 256; LAS float* HST = SEGH + 256;
    for (int i = ht; i < 2 * 64 * 64; i += 256) { const int g = i >> 12, d = (i >> 6) & 63, e = i & 63;
        WG[(g * 64 + e) * 72 + d] = (bf16_t)(pk2(A.gw[(((size_t)(dir * 2 + g) * 8 + nbk) * 64 + d) * 64 + e], 0.f) & 0xffffu); }
    for (int i = ht; i < 256; i += 256) CW[i] = A.convw[(i >> 6) * 512 + nbk * 64 + (i & 63)];
    if (ht < 128) HST[ht] = 0.f;
    if (ht < 64) { CB[ht] = A.convb[nbk * 64 + ht]; BRr[ht] = A.gb[(dir * 2 + 0) * 512 + nbk * 64 + ht]; BIi[ht] = A.gb[(dir * 2 + 1) * 512 + nbk * 64 + ht];
        const float lm = A.lam[dir * 512 + nbk * 64 + ht]; const float sp = (lm > 15.f) ? __expf(-lm) : log1pf(__expf(-lm)); C8[ht] = -8.f * sp * LOG2E; }
    const bf16_t* Px = A.P + 3072 + nbk * 64;
    u32x4 rx[3]; unsigned long long pr[4] = {0ull, 0ull, 0ull, 0ull}; int pmode = 0;
    bf16_t* const opb = A.SL + nbk * 64 + (ht & 3) * 16;
    int rowbase, pos0, slen; bool first, isx;
    chunk_geom(0, b, dir, rowbase, pos0, slen, first, isx);
#define LRU_LOAD() do { _Pragma("unroll") for (int q = 0; q < 3; ++q) { const int id = ht + 256 * q, i = id >> 3, c8 = id & 7; const int pos = pos0 - 2 + i; \
        rx[q] = (u32x4){0u, 0u, 0u, 0u}; if (id < 544 && pos >= 0 && pos < slen) rx[q] = __builtin_nontemporal_load((const u32x4*)(Px + (size_t)(rowbase - 2 + i) * NP + c8 * 8)); } \
        if (pmode == 1 && !late_pre(jnx)) { const int t = ht >> 2; const bf16_t* op = opb + (size_t)(rowbase + (dir ? 63 - t : t)) * 512; _Pragma("unroll") for (int q = 0; q < 4; ++q) pr[q] = ld8_coh(op + 4 * q); } } while (0)
    int jnx = 0;
    pmode = (A.last && !isx) ? 0 : pre_mode(first, 0);
    LRU_LOAD();
    LBAR();
    for (int j = 0; j < NSTEP; ++j) {
        const int orow = rowbase; const bool owrite = !(A.last && !isx); const int omode = pmode;
        if (late_pre(j) && pmode == 1) { const int t = ht >> 2; const bf16_t* op = opb + (size_t)(rowbase + (dir ? 63 - t : t)) * 512; _Pragma("unroll") for (int q = 0; q < 4; ++q) pr[q] = ld8_coh(op + 4 * q); }
        unsigned long long opr[4] = {pr[0], pr[1], pr[2], pr[3]};
        asm volatile("" : "+v"(opr[0]), "+v"(opr[1]), "+v"(opr[2]), "+v"(opr[3]));
#pragma unroll
        for (int q = 0; q < 3; ++q) { const int id = ht + 256 * q; if (id < 544) *(LAS u32x4*)(XR + (id >> 3) * 64 + (id & 7) * 8) = rx[q]; }
        LBAR();
        if (j + 1 < NSTEP) { chunk_geom(j + 1, b, dir, rowbase, pos0, slen, first, isx); pmode = (A.last && !isx) ? 0 : pre_mode(first, j + 1); jnx = j + 1; LRU_LOAD(); }
        { const int t = ht >> 2, d0 = (ht & 3) * 16, i0 = dir ? 63 - t : t; float xc[16];
#pragma unroll
            for (int e4 = 0; e4 < 4; ++e4) { const f32x4 c4 = *(const LAS f32x4*)(CB + d0 + 4 * e4); xc[4 * e4] = c4[0]; xc[4 * e4 + 1] = c4[1]; xc[4 * e4 + 2] = c4[2]; xc[4 * e4 + 3] = c4[3]; }
#pragma unroll
            for (int tap = 0; tap < 4; ++tap) { const u32x4 a0 = *(const LAS u32x4*)(XR + (i0 + tap) * 64 + d0), a1 = *(const LAS u32x4*)(XR + (i0 + tap) * 64 + d0 + 8);
                const unsigned ww[8] = {a0.x, a0.y, a0.z, a0.w, a1.x, a1.y, a1.z, a1.w};
#pragma unroll
                for (int e4 = 0; e4 < 4; ++e4) { const f32x4 w4 = *(const LAS f32x4*)(CW + tap * 64 + d0 + 4 * e4);
                    xc[4 * e4] += w4[0] * bflo(ww[2 * e4]); xc[4 * e4 + 1] += w4[1] * bfhi(ww[2 * e4]); xc[4 * e4 + 2] += w4[2] * bflo(ww[2 * e4 + 1]); xc[4 * e4 + 3] += w4[3] * bfhi(ww[2 * e4 + 1]); } }
            u32x4 w0, w1; w0.x = pk2(xc[0], xc[1]); w0.y = pk2(xc[2], xc[3]); w0.z = pk2(xc[4], xc[5]); w0.w = pk2(xc[6], xc[7]); w1.x = pk2(xc[8], xc[9]); w1.y = pk2(xc[10], xc[11]); w1.z = pk2(xc[12], xc[13]); w1.w = pk2(xc[14], xc[15]);
            *(LAS u32x4*)(XC + t * 72 + d0) = w0; *(LAS u32x4*)(XC + t * 72 + d0 + 8) = w1; }
        LBAR();
        { const int t = 16 * hw + fr;
#pragma unroll
            for (int et = 0; et < 4; ++et) { f32x4 ar = (f32x4){0.f, 0.f, 0.f, 0.f}, ai = (f32x4){0.f, 0.f, 0.f, 0.f};
#pragma unroll
                for (int kk = 0; kk < 2; ++kk) { const bf16x8 xb = ldfrag(XC, 72, 16 * hw, 32 * kk, lane);
                    ar = mfma16(ldfrag(WG, 72, 16 * et, 32 * kk, lane), xb, ar); ai = mfma16(ldfrag(WG + 64 * 72, 72, 16 * et, 32 * kk, lane), xb, ai); }
                const int e0 = 16 * et + 4 * fq; f32x4 av, uv;
                const u32x2 xw = *(const LAS u32x2*)(XC + t * 72 + e0); const float xv[4] = {bflo(xw.x), bfhi(xw.x), bflo(xw.y), bfhi(xw.y)};
                const f32x4 br4 = *(const LAS f32x4*)(BRr + e0), bi4 = *(const LAS f32x4*)(BIi + e0), c84 = *(const LAS f32x4*)(C8 + e0);
#pragma unroll
                for (int i = 0; i < 4; ++i) { const float r = ar[i] + br4[i], g = ai[i] + bi4[i];
                    const float pa = 1.f + ex2(-LOG2E * r), pb = 1.f + ex2(-LOG2E * g);
                    const float pm = fminf(pa * pb, 3.0e38f), rinv = rcpf_(pm);
                    const float sr = fminf(pb, 3.0e38f) * rinv, sg = fminf(pa, 3.0e38f) * rinv;
                    const float al = ex2(c84[i] * sr);
                    av[i] = al; uv[i] = __builtin_amdgcn_sqrtf(fmaxf(1.f - al * al, 0.f)) * sg * xv[i]; }
                *(LAS f32x4*)(AA + t * 68 + e0) = av; *(LAS f32x4*)(UU + t * 68 + e0) = uv; } }
        LBAR();
        {
            float hv[16], av[16]; float ap = 1.f, hl = 0.f;
#pragma unroll
            for (int i = 0; i < 16; ++i) { const float al = AA[(16 * hw + i) * 68 + lane], uu = UU[(16 * hw + i) * 68 + lane]; hl = al * hl + uu; ap *= al; hv[i] = hl; av[i] = ap; }
            SEGA[hw * 64 + lane] = ap; SEGH[hw * 64 + lane] = hl;
            LBAR();
            float carry = HST[(j & 1) * 64 + lane];
            for (int sg = 0; sg < hw; ++sg) carry = SEGA[sg * 64 + lane] * carry + SEGH[sg * 64 + lane];
#pragma unroll
            for (int i = 0; i < 16; ++i) UU[(16 * hw + i) * 68 + lane] = hv[i] + av[i] * carry;
            if (hw == 3) HST[((j + 1) & 1) * 64 + lane] = hv[15] + av[15] * carry;
        }
        LBAR();
        if (owrite) { const int t = ht >> 2, d0 = (ht & 3) * 16; bf16_t* op = opb + (size_t)(orow + (dir ? 63 - t : t)) * 512;
#pragma unroll
            for (int q = 0; q < 4; ++q) out_put4(op + 4 * q, *(const LAS f32x4*)(UU + t * 68 + d0 + 4 * q), omode, opr[q]); }
        if (j == 1 || j == 35) asm volatile("s_waitcnt vmcnt(0)" ::: "memory");
    }
    LBAR();
#undef LRU_LOAD
}
DI void phase_scan(const ScanArgs& A, LAS unsigned char* lds, int gr, int gs) {
    for (int u = gr; u < 32; u += gs) {
#ifndef NO_HG
        if (u < 16) scan_hgrn2(A, lds, u);
#ifdef DBL_HG
        if (u < 16) { __syncthreads(); scan_hgrn2(A, lds, u); }
#endif
#endif
#ifndef NO_ML
        if (u >= 16 && u < 24) scan_mlstm(A, lds, u - 16);
#ifdef DBL_ML
        if (u >= 16 && u < 24) { __syncthreads(); scan_mlstm(A, lds, u - 16); }
#endif
#endif
#ifndef NO_LRU
        if (u >= 24) scan_lru(A, lds, u - 24);
#ifdef DBL_LRU
        if (u >= 24) { __syncthreads(); scan_lru(A, lds, u - 24); }
#endif
#endif
        __syncthreads();
    }
}


#ifdef PROBE_CS
DI void cksum(const void* p, size_t bytes, unsigned long long* dst, int gr, int gs) {
    const unsigned* w = (const unsigned*)p; const size_t n = bytes / 4; unsigned long long acc = 0;
    const int tid = otid();
    for (unsigned i = (unsigned)gr * 512u + (unsigned)tid; i < (unsigned)n; i += (unsigned)gs * 512u) acc += (unsigned long long)w[i] * (unsigned long long)((i & 1023u) + 1u);
#pragma unroll
    for (int o = 1; o < 64; o <<= 1) acc += __shfl_xor(acc, o);
    if ((tid & 63) == 0) atomicAdd(dst, acc);
}
__global__ void cs_compare(const unsigned long long* CS, float* out, int n) {
    const size_t gt = (size_t)blockIdx.x * blockDim.x + threadIdx.x, gs = (size_t)gridDim.x * blockDim.x;
    int code = 0;
    for (int p = 63; p >= 0; --p) if (CS[p] != CS[64 + p]) code = p + 1;
    for (size_t i = gt; i < (size_t)n; i += gs) out[i] = (i == 0) ? 1000.f * (float)code : 0.f;
}
#define CK(idx, ptr, bytes) do { if (l == PROBE_CS - 1) cksum(ptr, bytes, CSA + a.run * 64 + (idx), gr, gs); } while (0)
#else
#define CK(idx, ptr, bytes) do { } while (0)
#endif
DI unsigned xcc_id() { return (unsigned)__builtin_amdgcn_s_getreg((3 << 11) | 20) & 0xFu; }
DI void xsync(unsigned* bar, unsigned gs, unsigned& epoch) {
    asm volatile("s_waitcnt vmcnt(0) lgkmcnt(0)" ::: "memory");
    __syncthreads();
    epoch = __builtin_amdgcn_readfirstlane(epoch + 1u);
    if (threadIdx.x == 0) {
        const unsigned old = __hip_atomic_fetch_add(bar, 1u, __ATOMIC_RELAXED, __HIP_MEMORY_SCOPE_AGENT);
        if (old + 1u == epoch * gs) __hip_atomic_store(bar + 64, epoch, __ATOMIC_RELAXED, __HIP_MEMORY_SCOPE_AGENT);
        else while (__hip_atomic_load(bar + 64, __ATOMIC_RELAXED, __HIP_MEMORY_SCOPE_AGENT) < epoch) __builtin_amdgcn_s_sleep(1);
    }
    if (threadIdx.x < 64) {
        __builtin_amdgcn_fence(__ATOMIC_ACQUIRE, "agent");
        asm volatile("s_waitcnt vmcnt(0)" ::: "memory");
    }
    __syncthreads();
}
__global__ void __launch_bounds__(512, 2) fwd_kernel(KArgs a) {
    extern __shared__ __attribute__((aligned(16))) unsigned char lds_raw[];
    LAS unsigned char* lds = (LAS unsigned char*)lds_raw;
    cg::grid_group grid = cg::this_grid();
#define GSYNC() do { asm volatile("s_waitcnt vmcnt(0) lgkmcnt(0)" ::: "memory"); grid.sync(); if (threadIdx.x < 64) { __builtin_amdgcn_fence(__ATOMIC_ACQUIRE, "agent"); asm volatile("s_waitcnt vmcnt(0)" ::: "memory"); } __syncthreads(); } while (0)
    unsigned char* ws = a.ws;
    float* MOD = (float*)(ws + WS_MOD); float* BIASA = (float*)(ws + WS_BIAS); float* LB = (float*)(ws + WS_LB); float* MLG = (float*)(ws + WS_MLG);
    unsigned* CTL = (unsigned*)(ws + WS_CTL);
    unsigned char* wsw = ws + WS_W; float* CTXW = (float*)(ws + WS_CTXW);
    bf16_t* AS = (bf16_t*)(ws + WS_AS); bf16_t* SL = (bf16_t*)(ws + WS_SL); bf16_t* BR = (bf16_t*)(ws + WS_BR); bf16_t* P = (bf16_t*)(ws + WS_P);

    volatile LAS unsigned* GI = (volatile LAS unsigned*)(lds + LDS_BYTES - 64);
    const unsigned myx = xcc_id();
    if (threadIdx.x == 0) GI[0] = __hip_atomic_fetch_add(CTL + 64 * myx + a.run * 8192, 1u, __ATOMIC_RELAXED, __HIP_MEMORY_SCOPE_AGENT);
    phase_mod(a, lds, MOD, LB);
    phase_conv(a, lds, 0, wsw, BIASA);
    GSYNC();
    if (threadIdx.x == 0) { unsigned ng = 0, g = 0, gs = 1;
        for (unsigned x = 0; x < 16; ++x) { const unsigned c = __hip_atomic_load(CTL + 64 * x + a.run * 8192, __ATOMIC_RELAXED, __HIP_MEMORY_SCOPE_AGENT); if (c) { if (x == myx) { g = ng; gs = c; } ++ng; } }
        GI[1] = g; GI[2] = gs; GI[3] = ng; }
    __syncthreads();
    const int gr = __builtin_amdgcn_readfirstlane((int)GI[0]), gg = __builtin_amdgcn_readfirstlane((int)GI[1]), gs = __builtin_amdgcn_readfirstlane((int)GI[2]), ng = __builtin_amdgcn_readfirstlane((int)GI[3]);
    unsigned* bar = CTL + 2048 + 128 * gg + a.run * 4096; unsigned epoch = 0;
    unsigned long long* CSA = (unsigned long long*)(ws + WS_LB + 32768); (void)CSA;
#define XSYNC() xsync(bar, (unsigned)gs, epoch)
    constexpr int RB = 4352;

    for (int l = 0; l < DEPTH; ++l) {
        const bool last = (l == DEPTH - 1); const int cm = l & 1;
        const float* xs = (l == 0) ? a.in[0] : a.out; const float* cs = (l == 0) ? a.in[2] : CTXW;
        const float* modl = MOD + (size_t)l * 9 * 6144; const float* BIAS = BIASA + l * NW1;
        const int Mall = RB, Mx = last ? 4096 : RB;
        unsigned char* wl = (l & 1) ? ws + WS_W2 : wsw;
        const bf16_t* W1 = (const bf16_t*)(wl + W_W1); const bf16_t* WGt = W1 + (size_t)N1 * 1024; const bf16_t* WBR = (const bf16_t*)(wl + W_BR);
        const bf16_t* WO = (const bf16_t*)(wl + W_O); const bf16_t* WFI = (const bf16_t*)(wl + W_FI); const bf16_t* WFO = (const bf16_t*)(wl + W_FO);
        for (int b = gg; b < NB; b += ng) phase_norm(xs, cs, a.in[6] + l * 1024, modl, 0, 1, cm, AS + (size_t)b * RB * 1024, Mall, b, gr, gs);
        if (l > 0) GSYNC(); else XSYNC();
        for (int b = gg; b < NB; b += ng) { CK(3, AS + (size_t)b * RB * 1024, (size_t)RB * 2048); }
        for (int b = gg; b < NB; b += ng) { Epi1 E{P + (size_t)b * RB * NP, BR + (size_t)b * RB * 1536, MLG + (size_t)b * RB * 16, BIAS, LB + l * 1024}; run_gemm(lds, AS + (size_t)b * RB * 1024, W1, Mall, N1, 1024, E, gr, gs); }
        XSYNC();
        for (int b = gg; b < NB; b += ng) { CK(4, P + (size_t)b * RB * NP, (size_t)RB * NP * 2); CK(5, BR + (size_t)b * RB * 1536, (size_t)RB * 1024); CK(6, MLG + (size_t)b * RB * 16, (size_t)RB * 64); }
        for (int b = gg; b < NB; b += ng) { ScanArgs S{P + (size_t)b * RB * NP, MLG + (size_t)b * RB * 16, AS + (size_t)b * RB * 1024, SL + (size_t)b * RB * 512, a.in[12] + l * 4 * 512, a.in[13] + l * 512, a.in[14] + (size_t)l * 2 * 2 * 8 * 64 * 64, a.in[15] + l * 2 * 2 * 512, a.in[16] + l * 2 * 512, last ? 1 : 0};
            phase_scan(S, lds, gr, gs);
#ifdef DBL_SCAN
            phase_scan(S, lds, gr, gs);
#endif
            }
        XSYNC();
        for (int b = gg; b < NB; b += ng) { CK(7, AS + (size_t)b * RB * 1024, (size_t)RB * 2048); CK(8, SL + (size_t)b * RB * 512, (size_t)RB * 1024); }
        for (int b = gg; b < NB; b += ng) phase_fin(xs, cs, a.in[6] + l * 1024, modl, cm, AS + (size_t)b * RB * 1024, SL + (size_t)b * RB * 512, BR + (size_t)b * RB * 1536, a.in[10] + l * 512, a.in[11] + l * 512, Mx, b, gr, gs);
        XSYNC();
        for (int b = gg; b < NB; b += ng) { CK(9, AS + (size_t)b * RB * 1024, (size_t)RB * 2048); CK(10, BR + (size_t)b * RB * 1536, (size_t)RB * 1024); }
        for (int b = gg; b < NB; b += ng) { Epi2 E{P + (size_t)b * RB * NP, BIAS + N1}; run_gemm(lds, AS + (size_t)b * RB * 1024, WGt, Mx, NG, 1024, E, gr, gs); }
        XSYNC();
        for (int b = gg; b < NB; b += ng) { CK(11, P + (size_t)b * RB * NP, (size_t)RB * NG * 2); }
        for (int b = gg; b < NB; b += ng) { Epi3 E{P + (size_t)b * RB * NP, AS + (size_t)b * RB * 1024}; run_gemm(lds, BR + (size_t)b * RB * 1536, WBR, Mx, 1024, 1536, E, gr, gs); }
        XSYNC();
        for (int b = gg; b < NB; b += ng) { CK(12, AS + (size_t)b * RB * 1024, (size_t)RB * 2048); }
        for (int b = gg; b < NB; b += ng) { EpiRes E{xs, a.out, cs, CTXW, modl + 2 * 1024, cm, ((PROBE_MIX >> l) & 1) ? 0.f : 1.f, b}; run_gemm(lds, AS + (size_t)b * RB * 1024, WO, Mx, 1024, 1024, E, gr, gs); }
        XSYNC();
        for (int b = gg; b < NB; b += ng) { CK(13, a.out + (size_t)b * 4096 * 1024, (size_t)4096 * 4096); CK(14, CTXW + (size_t)b * 256 * 1024, (size_t)256 * 4096); }
        for (int b = gg; b < NB; b += ng) phase_norm(a.out, CTXW, a.in[19] + l * 1024, modl, 3, 4, 0, AS + (size_t)b * RB * 1024, Mx, b, gr, gs);
#ifdef DBL_P5
        for (int b = gg; b < NB; b += ng) phase_norm(a.out, CTXW, a.in[19] + l * 1024, modl, 3, 4, 0, AS + (size_t)b * RB * 1024, Mx, b, gr, gs);
#endif
        XSYNC();
        for (int b = gg; b < NB; b += ng) { CK(15, AS + (size_t)b * RB * 1024, (size_t)RB * 2048); }
        for (int b = gg; b < NB; b += ng) { Epi5 E{P + (size_t)b * RB * NP}; run_gemm(lds, AS + (size_t)b * RB * 1024, WFI, Mx, 2 * FF, 1024, E, gr, gs); }
#ifdef DBL_G5
        for (int b = gg; b < NB; b += ng) { Epi5 E{P + (size_t)b * RB * NP}; run_gemm(lds, AS + (size_t)b * RB * 1024, WFI, Mx, 2 * FF, 1024, E, gr, gs); }
#endif
        XSYNC();
        for (int b = gg; b < NB; b += ng) { CK(16, P + (size_t)b * RB * NP, (size_t)RB * FF * 2); }
        for (int b = gg; b < NB; b += ng) { EpiRes E{a.out, a.out, CTXW, CTXW, modl + 5 * 1024, 0, ((PROBE_FFN >> l) & 1) ? 0.f : 1.f, b}; run_gemm(lds, P + (size_t)b * RB * NP, WFO, Mx, 1024, FF, E, gr, gs); }
        if (!last) phase_conv_q(a, lds, l + 1, ((l + 1) & 1) ? ws + WS_W2 : wsw, BIASA, CTL + 12288 + 64 * l);
        XSYNC();
        for (int b = gg; b < NB; b += ng) { CK(17, a.out + (size_t)b * 4096 * 1024, (size_t)4096 * 4096); }
    }
    for (int b = gg; b < NB; b += ng) phase_final(a.out + (size_t)b * 4096 * 1024, a.in[22], gr, gs);
}

extern "C" void kernel_launch(void* const* d_in, const int* in_sizes, int n_in, void* d_out, int out_size, void* d_ws, size_t ws_size, hipStream_t stream) {
    static int grid = 0;
    if (grid == 0) {
        if (n_in != 23 || out_size != MX * D || ws_size < WS_END) { fprintf(stderr, "kernel_launch: unexpected problem (n_in %d out %d ws %zu need %zu)\n", n_in, out_size, ws_size, (size_t)WS_END); grid = -1; return; }
        int dev = 0, cus = 0, per_cu = 0;
        if (hipGetDevice(&dev) != hipSuccess || hipDeviceGetAttribute(&cus, hipDeviceAttributeMultiprocessorCount, dev) != hipSuccess) { grid = -1; return; }
        if (hipFuncSetAttribute((const void*)fwd_kernel, hipFuncAttributeMaxDynamicSharedMemorySize, LDS_BYTES) != hipSuccess) { fprintf(stderr, "kernel_launch: hipFuncSetAttribute failed\n"); grid = -1; return; }
        if (hipOccupancyMaxActiveBlocksPerMultiprocessor(&per_cu, (const void*)fwd_kernel, 512, LDS_BYTES) != hipSuccess || per_cu < 1) { fprintf(stderr, "kernel_launch: occupancy query says %d\n", per_cu); per_cu = 1; }
        (void)hipGetLastError();
        grid = cus * per_cu;
        if (grid > 256) grid = 256;
    }
    if (grid < 0) return;
    (void)hipMemsetAsync((char*)d_ws + WS_CTL, 0, 65536, stream);
    KArgs a{};
    for (int i = 0; i < 23; ++i) a.in[i] = (const float*)d_in[i];
    a.out = (float*)d_out; a.ws = (unsigned char*)d_ws;
    void* args[] = {&a};
#ifdef PROBE_CS
    (void)hipMemsetAsync((char*)d_ws + WS_LB + 32768, 0, 1024, stream);
    (void)hipLaunchCooperativeKernel((void*)fwd_kernel, dim3(grid), dim3(512), args, LDS_BYTES, stream);
    a.run = 1;
#endif
    hipError_t e = hipLaunchCooperativeKernel((void*)fwd_kernel, dim3(grid), dim3(512), args, LDS_BYTES, stream);
#ifdef PROBE_CS
    hipLaunchKernelGGL(cs_compare, dim3(1024), dim3(256), 0, stream, (const unsigned long long*)((char*)d_ws + WS_LB + 32768), (float*)d_out, out_size);
#endif
    if (e != hipSuccess) fprintf(stderr, "kernel_launch: cooperative launch failed: %s (grid %d)\n", hipGetErrorString(e), grid);
}
```
